# Optimizing an MI355X kernel written in HIP

```python
import math
import jax, jax.numpy as jnp
from jax import lax
import numpy as np

D_MODEL = 1024
BATCH = 8
SEQ = 2048
DEPTH = 2

CHUNK = 64
Q_BLOCK = 128
N_BRANCH = 3
BRANCH_WIDTH = D_MODEL // 2
ATT_HEADS = 4
ATT_QK_DIM = BRANCH_WIDTH // (2 * ATT_HEADS)
ATT_V_DIM = 2 * ATT_QK_DIM
ATT_QK_WIDTH = ATT_HEADS * 2 * ATT_QK_DIM
POOL_GROUPS = 4
POOL_WINDOWS = (2, 4, 8, 16)
POOL_GROUP_DIM = BRANCH_WIDTH // POOL_GROUPS
SGU_GROUPS = 4
SGU_BLOCK = 128
SGU_GROUP_DIM = BRANCH_WIDTH // SGU_GROUPS
IN_SPLIT_SIZES = (ATT_QK_WIDTH, ATT_QK_WIDTH, BRANCH_WIDTH, BRANCH_WIDTH,
                  BRANCH_WIDTH, BRANCH_WIDTH,
                  BRANCH_WIDTH, BRANCH_WIDTH, BRANCH_WIDTH)
IN_WIDTH = sum(IN_SPLIT_SIZES)
NORM_EPS = 1e-6

kernel_name = "hybrid_diffattn_pool_sgu_block"


def rms_norm(x, g):
    xf = x.astype(jnp.float32)
    y = xf * lax.rsqrt(jnp.mean(xf * xf, axis=-1, keepdims=True) + NORM_EPS)
    return (y * g.astype(jnp.float32)).astype(x.dtype)


def layer_norm(x, g, b):
    xf = x.astype(jnp.float32)
    mu = jnp.mean(xf, axis=-1, keepdims=True)
    var = jnp.mean(jnp.square(xf - mu), axis=-1, keepdims=True)
    y = (xf - mu) * lax.rsqrt(var + NORM_EPS)
    return (y * g.astype(jnp.float32) + b.astype(jnp.float32)).astype(x.dtype)


def diff_attention(q, k, v, lam):
    B, H, _, S, _ = q.shape
    key_chunk = jnp.arange(S) // CHUNK
    scale = ATT_QK_DIM ** -0.5

    def attend_block(start):
        qb = lax.dynamic_slice_in_dim(q, start, Q_BLOCK, axis=3)
        q_chunk = (start + jnp.arange(Q_BLOCK)) // CHUNK
        mask = key_chunk[None, :] <= q_chunk[:, None]
        s = jnp.einsum('bhmqd,bhmkd->bhmqk', qb, k).astype(jnp.float32) * scale
        s = jnp.where(mask, s, -jnp.inf)
        p = jax.nn.softmax(s, axis=-1)
        a = p[:, :, 0] - lam * p[:, :, 1]
        return jnp.einsum('bhqk,bhkd->bhqd', a.astype(v.dtype), v)

    starts = jnp.arange(S // Q_BLOCK) * Q_BLOCK
    o = lax.map(attend_block, starts)
    return o.transpose(1, 2, 0, 3, 4).reshape(B, H, S, ATT_V_DIM)


def multi_scale_pool(u, w, b, scale):
    B, S, _ = u.shape
    ug = u.reshape(B, S, POOL_GROUPS, POOL_GROUP_DIM)
    uf = ug.astype(jnp.float32)
    cs = jnp.pad(jnp.cumsum(uf, axis=1), ((0, 0), (1, 0), (0, 0), (0, 0)))
    t = jnp.arange(S)[:, None]
    win = jnp.array(POOL_WINDOWS, dtype=jnp.int32)[None, :]
    lo = jnp.maximum(t + 1 - win, 0)
    window_sum = cs[:, 1:] - cs[:, lo, jnp.arange(POOL_GROUPS)[None, :]]
    count = (t + 1 - lo).astype(jnp.float32)[None, :, :, None]
    pooled = (window_sum / count - uf).astype(u.dtype)
    mixed = jnp.einsum('bsgc,gcd->bsgd', pooled, w) + b
    return mixed.reshape(B, S, BRANCH_WIDTH) * scale


def spatial_gating(u, v, ln_g, ln_b, w_s, b_s):
    B, S, _ = u.shape
    nb = S // SGU_BLOCK
    u = jax.nn.gelu(u, approximate=False)
    v = layer_norm(jax.nn.gelu(v, approximate=False), ln_g, ln_b)
    vb = v.reshape(B, nb, SGU_BLOCK, SGU_GROUPS, SGU_GROUP_DIM)
    pos_chunk = jnp.arange(SGU_BLOCK) // CHUNK
    mask = pos_chunk[None, :] <= pos_chunk[:, None]
    w = jnp.where(mask[None], w_s, jnp.zeros_like(w_s))
    mixed = jnp.einsum('gij,bnjgc->bnigc', w, vb) + b_s.T[None, None, :, :, None]
    ub = u.reshape(B, nb, SGU_BLOCK, SGU_GROUPS, SGU_GROUP_DIM)
    return (ub * mixed).reshape(B, S, BRANCH_WIDTH)


def hybrid_layer(x, layer_idx, pre_g, post_g, w_in, lq1, lk1, lq2, lk2, subln_g,
                 pool_w, pool_b, pool_scale, sgu_ln_g, sgu_ln_b, sgu_w, sgu_b,
                 w_branch, w_merge, b_merge, w_out):
    B, S, D = x.shape
    h = rms_norm(x, pre_g)
    z = h @ w_in
    offsets = []
    acc = 0
    for size in IN_SPLIT_SIZES[:-1]:
        acc += size
        offsets.append(acc)
    q, k, v, g_a, p_in, g_b, s_u, s_v, g_c = jnp.split(z, offsets, axis=-1)

    q = q.reshape(B, S, ATT_HEADS, 2, ATT_QK_DIM).transpose(0, 2, 3, 1, 4)
    k = k.reshape(B, S, ATT_HEADS, 2, ATT_QK_DIM).transpose(0, 2, 3, 1, 4)
    v = v.reshape(B, S, ATT_HEADS, ATT_V_DIM).transpose(0, 2, 1, 3)
    lam_init = 0.8 - 0.6 * math.exp(-0.3 * layer_idx)
    f32 = jnp.float32
    lam = (jnp.exp(jnp.sum(lq1.astype(f32) * lk1.astype(f32)))
           - jnp.exp(jnp.sum(lq2.astype(f32) * lk2.astype(f32))) + lam_init)
    o = diff_attention(q, k, v, lam)
    o = rms_norm(o, subln_g) * (1.0 - lam_init)
    y_a = o.transpose(0, 2, 1, 3).reshape(B, S, BRANCH_WIDTH)

    y_b = multi_scale_pool(p_in, pool_w, pool_b, pool_scale)

    y_c = spatial_gating(s_u, s_v, sgu_ln_g, sgu_ln_b, sgu_w, sgu_b)

    ys = jnp.stack([y_a, y_b, y_c], axis=2) * jax.nn.silu(jnp.stack([g_a, g_b, g_c], axis=2))
    branch = jnp.einsum('bsnw,nwd->bsnd', ys, w_branch)
    gates = jax.nn.sigmoid(h @ w_merge + b_merge).reshape(B, S, N_BRANCH, D)
    merged = jnp.sum(gates * branch, axis=2)
    out = merged @ w_out
    return x + rms_norm(out, post_g)


def setup_inputs(seed: int = 0) -> dict:
    key = jax.random.key(seed)
    ks = jax.random.split(key, 24)
    n = jax.random.normal
    L, D, W = DEPTH, D_MODEL, BRANCH_WIDTH
    return {
        "x": n(ks[0], (BATCH, SEQ, D), jnp.float32),
        "pre_norm_g": 1.0 + 0.05 * n(ks[1], (L, D), jnp.float32),
        "post_norm_g": 1.0 + 0.05 * n(ks[2], (L, D), jnp.float32),
        "w_in": n(ks[3], (L, D, IN_WIDTH), jnp.float32) * D ** -0.5,
        "lambda_q1": 0.1 * n(ks[4], (L, ATT_QK_DIM), jnp.float32),
        "lambda_k1": 0.1 * n(ks[5], (L, ATT_QK_DIM), jnp.float32),
        "lambda_q2": 0.1 * n(ks[6], (L, ATT_QK_DIM), jnp.float32),
        "lambda_k2": 0.1 * n(ks[7], (L, ATT_QK_DIM), jnp.float32),
        "attn_subln_g": 1.0 + 0.05 * n(ks[8], (L, ATT_V_DIM), jnp.float32),
        "pool_w": n(ks[9], (L, POOL_GROUPS, POOL_GROUP_DIM, POOL_GROUP_DIM), jnp.float32) * POOL_GROUP_DIM ** -0.5,
        "pool_b": 0.02 * n(ks[10], (L, POOL_GROUPS, POOL_GROUP_DIM), jnp.float32),
        "pool_scale": 1.0 + 0.1 * n(ks[11], (L, W), jnp.float32),
        "sgu_ln_g": 1.0 + 0.05 * n(ks[12], (L, W), jnp.float32),
        "sgu_ln_b": 0.02 * n(ks[13], (L, W), jnp.float32),
        "sgu_w": n(ks[14], (L, SGU_GROUPS, SGU_BLOCK, SGU_BLOCK), jnp.float32) * SGU_BLOCK ** -0.5,
        "sgu_b": 1.0 + 0.05 * n(ks[15], (L, SGU_GROUPS, SGU_BLOCK), jnp.float32),
        "w_branch": n(ks[16], (L, N_BRANCH, W, D), jnp.float32) * W ** -0.5,
        "w_merge": n(ks[17], (L, D, N_BRANCH * D), jnp.float32) * D ** -0.5,
        "b_merge": 0.02 * n(ks[18], (L, N_BRANCH * D), jnp.float32),
        "w_out": n(ks[19], (L, D, D), jnp.float32) * D ** -0.5,
    }


def reference(x, pre_norm_g, post_norm_g, w_in, lambda_q1, lambda_k1, lambda_q2, lambda_k2,
              attn_subln_g, pool_w, pool_b, pool_scale, sgu_ln_g, sgu_ln_b, sgu_w, sgu_b,
              w_branch, w_merge, b_merge, w_out):
    for l in range(DEPTH):
        x = hybrid_layer(x, l, pre_norm_g[l], post_norm_g[l], w_in[l],
                         lambda_q1[l], lambda_k1[l], lambda_q2[l], lambda_k2[l], attn_subln_g[l],
                         pool_w[l], pool_b[l], pool_scale[l], sgu_ln_g[l], sgu_ln_b[l],
                         sgu_w[l], sgu_b[l], w_branch[l], w_merge[l], b_merge[l], w_out[l])
    return x
```

```cpp
#include <hip/hip_runtime.h>
#include <hip/hip_cooperative_groups.h>
#include <cstdio>
#include <cstdint>
namespace cg = cooperative_groups;

__device__ __forceinline__ int opaque_tid() { int t = threadIdx.x; asm volatile("" : "+v"(t)); return t; }
namespace pg8 {
#define PG8_LAS __attribute__((address_space(3)))
typedef unsigned short bf16_t;
typedef short bf16x8 __attribute__((ext_vector_type(8)));
typedef short s16x4 __attribute__((ext_vector_type(4)));
typedef float f32x4 __attribute__((ext_vector_type(4)));
typedef float f32x2 __attribute__((ext_vector_type(2)));
typedef unsigned u32x4 __attribute__((ext_vector_type(4)));
typedef unsigned u32x2 __attribute__((ext_vector_type(2)));
constexpr int BM = 256, BK = 64, HALF = 128, HTB = HALF * BK * 2  , STAGE_BYTES = 8 * HTB, NXCD = 8, WGM = 8;

__host__ __device__ __forceinline__ int lds_byte(int r, int c) { const int st = (r >> 4) * 2 + (c >> 5), rr = r & 15, cc = c & 31, ob = rr * 64 + cc * 2; return st * 1024 + (ob ^ (((ob >> 9) & 1) << 5)); }
__host__ __device__ __forceinline__ void stage_rc(int b, int& R, int& C) { const int st = b / 1024, sb = b % 1024, swz = sb ^ (((sb >> 9) & 1) << 5); R = (st >> 1) * 16 + swz / 64; C = (st & 1) * 32 + (swz % 64) / 2; }
__host__ __device__ __forceinline__ int perm32(int rho) { const int n = rho >> 4, i = rho & 15; return 8 * (i >> 2) + 4 * n + (i & 3); }

struct Unit { int pm, pn, kz, half; };
struct Gemm { const bf16_t* A; const bf16_t* Bt; int lda, ldb, K, kzstep; };

struct StaticOrder {
    int nM, nN, nwg, G, c;
    __host__ __device__ void init(int M, int N, int G_, int c_) { nM = M / BM; nN = N / BM; nwg = nM * nN; G = G_; c = c_; }
    __host__ __device__ bool next(int i, Unit& u) const {
        const long L = (long)i * G + c; if (L >= nwg) return false;
        int wgid = (int)L; { const int q = nwg / NXCD, r = nwg % NXCD, xcd = wgid % NXCD, off = wgid / NXCD; wgid = (xcd < r ? xcd * (q + 1) : r * (q + 1) + (xcd - r) * q) + off; }
        const int nig = WGM * nN, gid = wgid / nig, fm = gid * WGM, gsz = (nM - fm) < WGM ? (nM - fm) : WGM;
        u.pm = fm + ((wgid % nig) % gsz); u.pn = (wgid % nig) / gsz; u.kz = 0; u.half = 0; return true;
    }
    __device__ __forceinline__ void a_ready(const Unit&) const {}
    __device__ __forceinline__ void done(const Unit&) const {}
};
struct StaticOrderH {
    StaticOrder so;
    __host__ __device__ void init(int M, int N, int G_, int c_) { so.init(M, N, G_, c_); }
    __host__ __device__ bool next(int i, Unit& u) const {
        const int full = so.nwg / so.G, rem = so.nwg - full * so.G;
        if (i == full && rem * 2 == so.G) { StaticOrder t = so; t.c = so.c >> 1; if (!t.next(i, u)) return false; u.half = 1 + (so.c & 1); return true; }
        return so.next(i, u);
    }
    __device__ __forceinline__ void a_ready(const Unit&) const {}
    __device__ __forceinline__ void done(const Unit&) const {}
};
struct StaticOrder3 {
    StaticOrder so;
    __host__ __device__ void init(int M, int N, int G_, int c_) { so.init(M, N, G_, c_); }
    __host__ __device__ bool next(int i, Unit& u) const { if (!so.next(i / 3, u)) return false; u.kz = i % 3; return true; }
    __device__ __forceinline__ void a_ready(const Unit&) const {}
    __device__ __forceinline__ void done(const Unit&) const {}
};

__device__ __forceinline__ unsigned cvt_pk_bf16(float lo, float hi) { unsigned r; asm volatile("v_cvt_pk_bf16_f32 %0, %1, %2" : "=v"(r) : "v"(lo), "v"(hi)); return r; }
__device__ __forceinline__ f32x2 gelu_pk(f32x2 v) {
    const f32x2 av = __builtin_elementwise_abs(v), d = av * 0.2316418882f + 1.0f;
    f32x2 t; t.x = __builtin_amdgcn_rcpf(d.x); t.y = __builtin_amdgcn_rcpf(d.y);
    f32x2 q = t * 0.5307027145f + (-0.7265760135f); q = q * t + 0.7107068705f; q = q * t + (-0.142248368f); q = q * t + 0.127414796f; q = q * t;
    const f32x2 s = (v * v) * (-0.72134752044f);
    f32x2 e; e.x = __builtin_amdgcn_exp2f(s.x); e.y = __builtin_amdgcn_exp2f(s.y);
    const f32x2 m = v * (q * e), r = v - m;
    f32x2 o; o.x = v.x < 0.f ? m.x : r.x; o.y = v.y < 0.f ? m.y : r.y; return o;
}
__device__ __forceinline__ float sigmoid_f(float x) { return __builtin_amdgcn_rcpf(1.0f + __builtin_amdgcn_exp2f(-1.4426950408889634f * x)); }
__device__ __forceinline__ float bf2f(unsigned short b) { return __uint_as_float(((unsigned)b) << 16); }
__device__ __forceinline__ float bflo(unsigned w) { return __uint_as_float(w << 16); }
__device__ __forceinline__ float bfhi(unsigned w) { return __uint_as_float(w & 0xffff0000u); }

template <class Epi, class Sched, bool ALIGN_EPI = false, bool SP2 = false>
__device__ __forceinline__ void gemm_phase(PG8_LAS unsigned char* lds, const Gemm g, const Sched& S, const Epi& E) {
    const int tid = opaque_tid(), wid = __builtin_amdgcn_readfirstlane(tid >> 6), lane = tid & 63, wr = wid >> 2, wc = wid & 3, fr = lane & 15, fq = lane >> 4;
    const int K = g.K, nt = K / BK;
    unsigned voffA[2], voffB[2];
#pragma unroll
    for (int i = 0; i < 2; ++i) { int R, C; stage_rc(tid * 16 + i * 8192, R, C); const int Rb = Epi::PERM ? ((R & ~31) + perm32(R & 31)) : R;
        voffA[i] = (unsigned)(R * g.lda + C) * 2u; voffB[i] = (unsigned)(Rb * g.ldb + C) * 2u; }
    const size_t kstep = (size_t)(BK * 2);
    const size_t hstepA = (size_t)HALF * g.lda * 2, hstepB = (size_t)HALF * g.ldb * 2;
    const size_t tstepA = 2 * hstepA, tstepB = 2 * hstepB;
    const unsigned ldsw = (unsigned)wid * 1024u;
    const int aoff = lds_byte(wr * 64 + fr, fq * 8), boff = lds_byte(wc * 32 + fr, fq * 8);
#define PG8_SA(b, h) (((b) * 2 + (h)) * HTB)
#define PG8_SB(b, h) ((4 + (b) * 2 + (h)) * HTB)
#define PG8_STAGE(bufoff, gbase, voff) do { _Pragma("unroll") for (int _i = 0; _i < 2; ++_i) \
        __builtin_amdgcn_global_load_lds((const unsigned*)((const char*)(gbase) + (voff)[_i]), (PG8_LAS unsigned*)(lds + (bufoff) + ldsw + _i * 8192), 16, 0, 0); } while (0)
#define PG8_LDA(dst, b, h) do { _Pragma("unroll") for (int m = 0; m < 4; ++m) _Pragma("unroll") for (int k = 0; k < 2; ++k) dst[m][k] = *(const PG8_LAS bf16x8*)(lds + PG8_SA(b, h) + aoff + m * 2048 + k * 1024); } while (0)
#define PG8_LDB(dst, b, h) do { _Pragma("unroll") for (int n = 0; n < 2; ++n) _Pragma("unroll") for (int k = 0; k < 2; ++k) dst[n][k] = *(const PG8_LAS bf16x8*)(lds + PG8_SB(b, h) + boff + n * 2048 + k * 1024); } while (0)
#define PG8_MMA(ai, bj, At, Bt) do { __builtin_amdgcn_s_setprio(1); _Pragma("unroll") for (int m = 0; m < 4; ++m) _Pragma("unroll") for (int n = 0; n < 2; ++n) _Pragma("unroll") for (int k = 0; k < 2; ++k) \
        acc[ai][bj][m][n] = __builtin_amdgcn_mfma_f32_16x16x32_bf16(Bt[n][k], At[m][k], acc[ai][bj][m][n], 0, 0, 0); __builtin_amdgcn_s_setprio(0); } while (0)
#define PG8_WAIT_V(n) asm volatile("s_waitcnt vmcnt(" #n ")" ::: "memory")
#define PG8_WAIT_L(n) asm volatile("s_waitcnt lgkmcnt(" #n ")" ::: "memory")
#define PG8_BAR __builtin_amdgcn_s_barrier()
#define PG8_SCHED __builtin_amdgcn_sched_barrier(0)
    Unit cur, nxt; int ui = 0;
    if (!S.next(0, cur)) return;
    f32x4 acc[2][2][4][2];
#pragma unroll
    for (int a = 0; a < 2; ++a)
#pragma unroll
        for (int b = 0; b < 2; ++b)
#pragma unroll
            for (int m = 0; m < 4; ++m)
#pragma unroll
                for (int n = 0; n < 2; ++n) acc[a][b][m][n] = (f32x4){0.f, 0.f, 0.f, 0.f};
    bf16x8 At[4][2], B0[2][2], B1[2][2];
    const char* cA = (const char*)g.A + (size_t)cur.pm * tstepA + (size_t)cur.kz * g.kzstep + (cur.half == 2 ? hstepA : (size_t)0); const char* cB = (const char*)g.Bt + (size_t)cur.pn * tstepB + (size_t)cur.kz * g.kzstep;
    S.a_ready(cur);
    if constexpr (SP2) {
        PG8_STAGE(PG8_SB(0, 0), cB, voffB); PG8_STAGE(PG8_SB(0, 1), cB + hstepB, voffB); PG8_STAGE(PG8_SA(0, 0), cA, voffA); PG8_STAGE(PG8_SA(0, 1), cA + hstepA, voffA);
        if (wr == 1) PG8_BAR;
        PG8_WAIT_V(2); PG8_BAR;
        PG8_STAGE(PG8_SB(1, 0), cB + kstep, voffB); PG8_STAGE(PG8_SA(1, 0), cA + kstep, voffA); PG8_STAGE(PG8_SB(1, 1), cB + hstepB + kstep, voffB);
        PG8_WAIT_V(6); PG8_BAR;
    } else {
        PG8_STAGE(PG8_SB(0, 0), cB, voffB); PG8_STAGE(PG8_SA(0, 0), cA, voffA); PG8_STAGE(PG8_SB(0, 1), cB + hstepB, voffB); PG8_STAGE(PG8_SA(0, 1), cA + hstepA, voffA);
        if (wr == 1) PG8_BAR;
        PG8_WAIT_V(4); PG8_BAR;
        PG8_STAGE(PG8_SB(1, 0), cB + kstep, voffB); PG8_STAGE(PG8_SA(1, 0), cA + kstep, voffA); PG8_STAGE(PG8_SB(1, 1), cB + hstepB + kstep, voffB);
        PG8_WAIT_V(6); PG8_BAR;
    }
    for (;;) {
        const bool has_next = S.next(ui + 1, nxt);
        const char* nA = has_next ? (const char*)g.A + (size_t)nxt.pm * tstepA + (size_t)nxt.kz * g.kzstep + (nxt.half == 2 ? hstepA : (size_t)0) : cA; const char* nB = has_next ? (const char*)g.Bt + (size_t)nxt.pn * tstepB + (size_t)nxt.kz * g.kzstep : cB;
        const bool whole = (cur.half == 0);
        for (int t = 0; t < nt; t += 2) {
            const bool last = (t == nt - 2);
            const char* a1 = cA + (size_t)(t + 1) * kstep;
            const char* a2 = last ? nA : cA + (size_t)(t + 2) * kstep; const char* b2 = last ? nB : cB + (size_t)(t + 2) * kstep;
            const char* a3 = a2 + kstep; const char* b3 = b2 + kstep;
            if (last && has_next) S.a_ready(nxt);
            if constexpr (SP2) {
            PG8_LDB(B0, 0, 0); PG8_LDB(B1, 0, 1); PG8_SCHED; PG8_LDA(At, 0, 0); PG8_STAGE(PG8_SA(1, 1), a1 + hstepA, voffA);
            PG8_WAIT_V(8); PG8_WAIT_L(0); PG8_BAR; PG8_MMA(0, 0, At, B0); PG8_MMA(0, 1, At, B1); PG8_BAR; PG8_SCHED;
            PG8_LDA(At, 0, 1); PG8_STAGE(PG8_SB(0, 0), b2, voffB); PG8_STAGE(PG8_SB(0, 1), b2 + hstepB, voffB); PG8_STAGE(PG8_SA(0, 0), a2, voffA);
            PG8_WAIT_V(8); PG8_WAIT_L(0); PG8_BAR; if (whole) { PG8_MMA(1, 0, At, B0); PG8_MMA(1, 1, At, B1); } PG8_BAR; PG8_SCHED;
            PG8_LDB(B0, 1, 0); PG8_LDB(B1, 1, 1); PG8_SCHED; PG8_LDA(At, 1, 0); PG8_STAGE(PG8_SA(0, 1), a2 + hstepA, voffA);
            PG8_WAIT_V(8); PG8_WAIT_L(0); PG8_BAR; PG8_MMA(0, 0, At, B0); PG8_MMA(0, 1, At, B1); PG8_BAR; PG8_SCHED;
            PG8_LDA(At, 1, 1); PG8_STAGE(PG8_SB(1, 0), b3, voffB); PG8_STAGE(PG8_SB(1, 1), b3 + hstepB, voffB); PG8_STAGE(PG8_SA(1, 0), a3, voffA);
            PG8_WAIT_V(8); PG8_WAIT_L(0); PG8_BAR; if (whole) { PG8_MMA(1, 0, At, B0); PG8_MMA(1, 1, At, B1); } PG8_BAR; PG8_SCHED;
            } else {
            PG8_LDB(B0, 0, 0); PG8_SCHED; PG8_LDA(At, 0, 0); PG8_STAGE(PG8_SA(1, 1), a1 + hstepA, voffA);
            PG8_WAIT_L(8); PG8_BAR; PG8_WAIT_L(0); PG8_MMA(0, 0, At, B0); PG8_BAR; PG8_SCHED;
            PG8_LDB(B1, 0, 1); PG8_STAGE(PG8_SB(0, 0), b2, voffB);
            PG8_BAR; PG8_WAIT_L(0); PG8_MMA(0, 1, At, B1); PG8_BAR;
            PG8_LDA(At, 0, 1); PG8_STAGE(PG8_SA(0, 0), a2, voffA);
            PG8_BAR; PG8_WAIT_L(0); PG8_MMA(1, 0, At, B0); PG8_BAR; PG8_SCHED;
            PG8_STAGE(PG8_SB(0, 1), b2 + hstepB, voffB);
            PG8_WAIT_V(6); PG8_BAR; PG8_MMA(1, 1, At, B1); PG8_BAR;
            PG8_LDB(B0, 1, 0); PG8_SCHED; PG8_LDA(At, 1, 0); PG8_STAGE(PG8_SA(0, 1), a2 + hstepA, voffA);
            PG8_WAIT_L(8); PG8_BAR; PG8_WAIT_L(0); PG8_MMA(0, 0, At, B0); PG8_BAR; PG8_SCHED;
            PG8_LDB(B1, 1, 1); PG8_STAGE(PG8_SB(1, 0), b3, voffB);
            PG8_BAR; PG8_WAIT_L(0); PG8_MMA(0, 1, At, B1); PG8_BAR;
            PG8_LDA(At, 1, 1); PG8_STAGE(PG8_SA(1, 0), a3, voffA);
            PG8_BAR; PG8_WAIT_L(0); PG8_MMA(1, 0, At, B0); PG8_BAR; PG8_SCHED;
            PG8_STAGE(PG8_SB(1, 1), b3 + hstepB, voffB);
            PG8_WAIT_V(6); PG8_BAR; PG8_MMA(1, 1, At, B1); PG8_BAR;
            }
        }
        if constexpr (ALIGN_EPI) { if (wr == 0) PG8_BAR; }
        if constexpr (!Epi::AFTER_DRAIN) { E(acc, cur, wr, wc, fr, fq); S.done(cur); }
        if (!has_next) break;
        if (!Epi::keep_acc(cur)) {
#pragma unroll
        for (int a = 0; a < 2; ++a)
#pragma unroll
            for (int b = 0; b < 2; ++b)
#pragma unroll
                for (int m = 0; m < 4; ++m)
#pragma unroll
                    for (int n = 0; n < 2; ++n) acc[a][b][m][n] = (f32x4){0.f, 0.f, 0.f, 0.f};
        }
        cur = nxt; cA = nA; cB = nB; ++ui;
        if constexpr (ALIGN_EPI) { if (wr == 1) PG8_BAR; }
    }
    PG8_WAIT_V(0);
    if constexpr (!ALIGN_EPI) { if (wr == 0) PG8_BAR; }
    PG8_BAR;
    if constexpr (Epi::AFTER_DRAIN) { E.fused(acc, cur, wr, wc, fr, fq, lds, wid, lane); S.done(cur); }
#undef PG8_SA
#undef PG8_SB
#undef PG8_STAGE
#undef PG8_LDA
#undef PG8_LDB
#undef PG8_MMA
#undef PG8_WAIT_V
#undef PG8_WAIT_L
#undef PG8_BAR
#undef PG8_SCHED
}

constexpr float QSCALE = 0.125f * 1.4426950408889634f;
__device__ __forceinline__ float act_apply1(float v, int act) { return v; }

__device__ __forceinline__ float dpp_xor1(float v) { return __uint_as_float((unsigned)__builtin_amdgcn_mov_dpp((int)__float_as_uint(v), 0xB1, 0xF, 0xF, true)); }
__device__ __forceinline__ float dpp_xor2(float v) { return __uint_as_float((unsigned)__builtin_amdgcn_mov_dpp((int)__float_as_uint(v), 0x4E, 0xF, 0xF, true)); }
__device__ __forceinline__ void quad_transpose(f32x4& r, int li) {
    const bool o1 = (li & 1) != 0, o2 = (li & 2) != 0;
#pragma unroll
    for (int t = 0; t < 2; ++t) { const float a = r[2 * t], b = r[2 * t + 1]; const float rcv = dpp_xor1(o1 ? a : b); r[2 * t] = o1 ? rcv : a; r[2 * t + 1] = o1 ? b : rcv; }
#pragma unroll
    for (int x = 0; x < 2; ++x) { const float a = r[x], b = r[x + 2]; const float rcv = dpp_xor2(o2 ? a : b); r[x] = o2 ? rcv : a; r[x + 2] = o2 ? b : rcv; }
}
struct EpiZ {
    static constexpr bool PERM = true, AFTER_DRAIN = false;
    static __device__ __forceinline__ bool keep_acc(const Unit&) { return false; }
    bf16_t* R1; bf16_t* R2; bf16_t* VT; f32x2* SVST;
    __device__ __forceinline__ void operator()(const f32x4 (&acc)[2][2][4][2], const Unit& u, int wr, int wc, int fr, int fq) const {
        const int kind = u.pn >> 1, half = u.pn & 1;
        const int row0 = u.pm * BM + (u.half == 2 ? HALF : 0) + wr * 64 + fr; const int nai = u.half ? 1 : 2;
        if (kind == 2) {
            const int rowb = u.pm * BM + (u.half == 2 ? HALF : 0) + wr * 64, q = fr >> 2, li = fr & 3;
#pragma unroll
            for (int ai = 0; ai < 2; ++ai) { if (ai >= nai) break;
#pragma unroll
                for (int mp = 0; mp < 2; ++mp) {
                    const int r = rowb + ai * HALF + mp * 32; const int b = r >> 11, sb = (r & 2047) + q * 8;
#pragma unroll
                    for (int bj = 0; bj < 2; ++bj) {
                        const int cv = half * 256 + bj * HALF + wc * 32 + 8 * fq; const int hh = cv >> 7, dv = cv & 127;
#pragma unroll
                        for (int n = 0; n < 2; ++n) {
                            f32x4 x = acc[ai][bj][2 * mp][n], y = acc[ai][bj][2 * mp + 1][n];
                            quad_transpose(x, li); quad_transpose(y, li);
                            u32x4 w; w.x = cvt_pk_bf16(x[0], x[1]); w.y = cvt_pk_bf16(x[2], x[3]); w.z = cvt_pk_bf16(y[0], y[1]); w.w = cvt_pk_bf16(y[2], y[3]);
                            *(u32x4*)(VT + ((size_t)((b * 4 + hh) * 128 + dv + 4 * n + li)) * 2048 + sb) = w;
                        }
                    }
                } }
            return;
        }
        int act = 0; float sc = 1.f; bf16_t* dst = R2; int ld = 2560, cb = 0;
        if (kind == 0) { dst = R1; ld = 1536; cb = 0; sc = QSCALE; }
        else if (kind == 1) { cb = 0; }
        else if (kind == 3) { cb = 512; act = 1; }
        else if (kind == 4) { cb = 1024; }
        else if (kind == 5) { dst = R1; ld = 1536; cb = 512; act = 1; }
        else if (kind == 6) { cb = 1536; act = 2; }
        else if (kind == 7) { cb = 2048; act = 2; }
        else { dst = R1; ld = 1536; cb = 1024; act = 1; }
        const int col0 = cb + half * 256 + wc * 32 + 8 * fq;
#pragma unroll
        for (int ai = 0; ai < 2; ++ai) { if (ai >= nai) break;
#pragma unroll
            for (int m = 0; m < 4; ++m) { bf16_t* rowp = dst + (size_t)(row0 + ai * HALF + m * 16) * ld + col0; float ssum = 0.f, ssq = 0.f;
#pragma unroll
                for (int bj = 0; bj < 2; ++bj) { f32x4 v0 = acc[ai][bj][m][0], v1 = acc[ai][bj][m][1];
                    if (act == 2) { f32x2 a = gelu_pk((f32x2){v0[0], v0[1]}), b = gelu_pk((f32x2){v0[2], v0[3]}), c = gelu_pk((f32x2){v1[0], v1[1]}), d = gelu_pk((f32x2){v1[2], v1[3]});
                        v0 = (f32x4){a.x, a.y, b.x, b.y}; v1 = (f32x4){c.x, c.y, d.x, d.y};
                        if (kind == 7) { ssum += ((v0[0] + v0[1]) + (v0[2] + v0[3])) + ((v1[0] + v1[1]) + (v1[2] + v1[3]));
                            ssq += ((v0[0] * v0[0] + v0[1] * v0[1]) + (v0[2] * v0[2] + v0[3] * v0[3])) + ((v1[0] * v1[0] + v1[1] * v1[1]) + (v1[2] * v1[2] + v1[3] * v1[3])); } }
                    else if (act == 1) {
#pragma unroll
                        for (int e = 0; e < 4; ++e) { v0[e] = v0[e] * sigmoid_f(v0[e]); v1[e] = v1[e] * sigmoid_f(v1[e]); } }
                    v0 = v0 * sc; v1 = v1 * sc; u32x4 w; w.x = cvt_pk_bf16(v0[0], v0[1]); w.y = cvt_pk_bf16(v0[2], v0[3]); w.z = cvt_pk_bf16(v1[0], v1[1]); w.w = cvt_pk_bf16(v1[2], v1[3]);
                    *(u32x4*)(rowp + bj * HALF) = w; }
                if (kind == 7) { ssum += __shfl_xor(ssum, 16); ssum += __shfl_xor(ssum, 32); ssq += __shfl_xor(ssq, 16); ssq += __shfl_xor(ssq, 32);
                    if (fq == 0) SVST[(size_t)(row0 + ai * HALF + m * 16) * 8 + half * 4 + wc] = (f32x2){ssum, ssq}; } } }
    }
};

__device__ __forceinline__ size_t gate_img(int pm, int pn, int wr, int wc, int fr, int fq) { return ((size_t)(pm * 12 + pn) * 8 + (wr * 4 + wc)) * 8192 + (size_t)(fq * 16 + fr) * 8; }
struct EpiGate {
    static constexpr bool PERM = true, AFTER_DRAIN = false;
    static __device__ __forceinline__ bool keep_acc(const Unit&) { return false; }
    bf16_t* O; const float* bias;
    __device__ __forceinline__ void operator()(const f32x4 (&acc)[2][2][4][2], const Unit& u, int wr, int wc, int fr, int fq) const {
        const int col0 = u.pn * BM + wc * 32 + 8 * fq;
        bf16_t* img = O + gate_img(u.pm, u.pn, wr, wc, fr, fq);
        f32x4 bv[2][2];
#pragma unroll
        for (int bj = 0; bj < 2; ++bj)
#pragma unroll
            for (int n = 0; n < 2; ++n) bv[bj][n] = *(const f32x4*)(bias + col0 + bj * HALF + 4 * n);
#pragma unroll
        for (int ai = 0; ai < 2; ++ai)
#pragma unroll
            for (int m = 0; m < 4; ++m)
#pragma unroll
                for (int bj = 0; bj < 2; ++bj) { f32x4 v0 = acc[ai][bj][m][0] + bv[bj][0], v1 = acc[ai][bj][m][1] + bv[bj][1];
#pragma unroll
                    for (int e = 0; e < 4; ++e) { v0[e] = fmaxf(sigmoid_f(v0[e]), 1e-18f); v1[e] = fmaxf(sigmoid_f(v1[e]), 1e-18f); }
                    u32x4 w; w.x = cvt_pk_bf16(v0[0], v0[1]); w.y = cvt_pk_bf16(v0[2], v0[3]); w.z = cvt_pk_bf16(v1[0], v1[1]); w.w = cvt_pk_bf16(v1[2], v1[3]);
                    *(u32x4*)(img + ((ai * 4 + m) * 2 + bj) * 512) = w; }
    }
};

struct EpiMerge {
    static constexpr bool PERM = true, AFTER_DRAIN = false;
    static __device__ __forceinline__ bool keep_acc(const Unit& u) { return u.kz < 2; }
    const bf16_t* G; bf16_t* O;
    __device__ __forceinline__ void operator()(f32x4 (&acc)[2][2][4][2], const Unit& u, int wr, int wc, int fr, int fq) const {
        const int row0 = u.pm * BM + wr * 64 + fr; const int col0 = u.pn * BM + wc * 32 + 8 * fq;
        if (u.kz < 2) {
        const bf16_t* ia = G + gate_img(u.pm, u.kz * 4 + u.pn, wr, wc, fr, fq); const bf16_t* ib = G + gate_img(u.pm, (u.kz + 1) * 4 + u.pn, wr, wc, fr, fq);
#pragma unroll
        for (int ai = 0; ai < 2; ++ai)
#pragma unroll
            for (int m = 0; m < 4; ++m) {
#pragma unroll
                for (int bj = 0; bj < 2; ++bj) { const int idx = ((ai * 4 + m) * 2 + bj) * 512; const u32x4 a = *(const u32x4*)(ia + idx), b = *(const u32x4*)(ib + idx);
                    f32x4 r0, r1;
                    r0[0] = bflo(a.x) * __builtin_amdgcn_rcpf(bflo(b.x)); r0[1] = bfhi(a.x) * __builtin_amdgcn_rcpf(bfhi(b.x));
                    r0[2] = bflo(a.y) * __builtin_amdgcn_rcpf(bflo(b.y)); r0[3] = bfhi(a.y) * __builtin_amdgcn_rcpf(bfhi(b.y));
                    r1[0] = bflo(a.z) * __builtin_amdgcn_rcpf(bflo(b.z)); r1[1] = bfhi(a.z) * __builtin_amdgcn_rcpf(bfhi(b.z));
                    r1[2] = bflo(a.w) * __builtin_amdgcn_rcpf(bflo(b.w)); r1[3] = bfhi(a.w) * __builtin_amdgcn_rcpf(bfhi(b.w));
                    acc[ai][bj][m][0] = acc[ai][bj][m][0] * r0; acc[ai][bj][m][1] = acc[ai][bj][m][1] * r1; }
                if (m == 3) asm volatile("" ::: "memory"); }
        } else {
        const bf16_t* ia = G + gate_img(u.pm, 8 + u.pn, wr, wc, fr, fq);
#pragma unroll
        for (int ai = 0; ai < 2; ++ai)
#pragma unroll
            for (int m = 0; m < 4; ++m) { const size_t r = (size_t)(row0 + ai * HALF + m * 16);
#pragma unroll
                for (int bj = 0; bj < 2; ++bj) { const u32x4 a = *(const u32x4*)(ia + ((ai * 4 + m) * 2 + bj) * 512);
                    f32x4 v0 = acc[ai][bj][m][0], v1 = acc[ai][bj][m][1];
                    v0[0] *= bflo(a.x); v0[1] *= bfhi(a.x); v0[2] *= bflo(a.y); v0[3] *= bfhi(a.y);
                    v1[0] *= bflo(a.z); v1[1] *= bfhi(a.z); v1[2] *= bflo(a.w); v1[3] *= bfhi(a.w);
                    u32x4 w; w.x = cvt_pk_bf16(v0[0], v0[1]); w.y = cvt_pk_bf16(v0[2], v0[3]); w.z = cvt_pk_bf16(v1[0], v1[1]); w.w = cvt_pk_bf16(v1[2], v1[3]);
                    *(u32x4*)(O + r * 1024 + col0 + bj * HALF) = w; } }
        }
    }
};

struct EpiOut {
    static constexpr bool PERM = true, AFTER_DRAIN = false;
    static __device__ __forceinline__ bool keep_acc(const Unit&) { return false; }
    bf16_t* O; float* ssq;
    __device__ __forceinline__ void operator()(const f32x4 (&acc)[2][2][4][2], const Unit& u, int wr, int wc, int fr, int fq) const {
        const int row0 = u.pm * BM + wr * 64 + fr; const int col0 = u.pn * BM + wc * 32 + 8 * fq;
#pragma unroll
        for (int ai = 0; ai < 2; ++ai)
#pragma unroll
            for (int m = 0; m < 4; ++m) { const size_t r = (size_t)(row0 + ai * HALF + m * 16); float s = 0.f;
#pragma unroll
                for (int bj = 0; bj < 2; ++bj) { const f32x4 v0 = acc[ai][bj][m][0], v1 = acc[ai][bj][m][1];
                    s += (v0[0] * v0[0] + v0[1] * v0[1]) + (v0[2] * v0[2] + v0[3] * v0[3]) + (v1[0] * v1[0] + v1[1] * v1[1]) + (v1[2] * v1[2] + v1[3] * v1[3]);
                    u32x4 w; w.x = cvt_pk_bf16(v0[0], v0[1]); w.y = cvt_pk_bf16(v0[2], v0[3]); w.z = cvt_pk_bf16(v1[0], v1[1]); w.w = cvt_pk_bf16(v1[2], v1[3]);
                    *(u32x4*)(O + r * 1024 + col0 + bj * HALF) = w; }
                s += __shfl_xor(s, 16); s += __shfl_xor(s, 32);
                if (fq == 0) ssq[r * 16 + u.pn * 4 + wc] = s; }
    }
};
}

using pg8::bf16_t; using pg8::bf16x8; using pg8::s16x4; using pg8::f32x4; using pg8::f32x2; using pg8::u32x4; using pg8::u32x2;
#define LAS __attribute__((address_space(3)))
constexpr int NWAVES = 8, NTHREADS = 512;
constexpr int BATCH = 8, SEQ = 2048, D = 1024, M = BATCH * SEQ, DEPTH = 2, INW = 4608, GATEW = 3072, BW = 512;
constexpr int R1_LD = 1536, R2_LD = 2560;
constexpr float EPS = 1e-6f;
constexpr size_t MiB = 1u << 20;
constexpr size_t WS_WCAT = 0;
constexpr size_t WCAT_L = (size_t)7680 * 1024;
constexpr size_t WS_WB = 32 * MiB;
constexpr size_t WB_L = (size_t)1024 * 1536;
constexpr size_t WS_WO = 40 * MiB;
constexpr size_t WO_L = (size_t)1024 * 1024;
constexpr size_t WS_PW = 44 * MiB;
constexpr size_t WS_SW = 44 * MiB + 512 * 1024;
constexpr size_t WS_H = 48 * MiB;
constexpr size_t WS_R1 = 80 * MiB;
constexpr size_t WS_R2 = 128 * MiB;
constexpr size_t WS_VT = 208 * MiB;
constexpr size_t WS_GATE = 128 * MiB;
constexpr size_t WS_OUT = 128 * MiB;
constexpr size_t WS_SSQ = 39 * MiB;
constexpr size_t WS_SVST = 45 * MiB;
constexpr size_t WS_CTL = 46 * MiB;
constexpr size_t WS_X1 = 224 * MiB;
constexpr size_t WS_END = 256 * MiB;
constexpr int LDS_BYTES = 132 * 1024;

__device__ __forceinline__ float wave_sum(float v) {
#pragma unroll
    for (int o = 1; o < 64; o <<= 1) v += __shfl_xor(v, o);
    return v;
}
__device__ __forceinline__ unsigned f2bf(float f) { unsigned u = __builtin_bit_cast(unsigned, f); return (u + 0x7fffu + ((u >> 16) & 1u)) >> 16; }
__device__ __forceinline__ unsigned pk2(float lo, float hi) { return f2bf(lo) | (f2bf(hi) << 16); }
#define LDS_WAIT() asm volatile("s_waitcnt lgkmcnt(0)" ::: "memory")

__device__ __forceinline__ void p0_transpose_item(const float* W, int N, bf16_t* WT, int ldo, int col_off, LAS float* scr, int item, int lane) {
    const int nblk = N / 32, kb = item / nblk, nb = item % nblk, k0 = 64 * kb, n0 = 32 * nb;
    float wv[32];
#pragma unroll
    for (int i = 0; i < 32; ++i) { const int kk = 2 * i + (lane >> 5); wv[i] = W[(size_t)(k0 + kk) * N + n0 + (lane & 31)]; }
#pragma unroll
    for (int i = 0; i < 32; ++i) { const int kk = 2 * i + (lane >> 5); scr[kk * 33 + (lane & 31)] = wv[i]; }
    LDS_WAIT(); asm volatile("" ::: "memory");
    const int c = lane & 7;
#pragma unroll
    for (int j = 0; j < 4; ++j) { const int n = (lane >> 3) + 8 * j; const LAS float* s = scr + (8 * c) * 33 + n;
        u32x4 o; o.x = pk2(s[0 * 33], s[1 * 33]); o.y = pk2(s[2 * 33], s[3 * 33]); o.z = pk2(s[4 * 33], s[5 * 33]); o.w = pk2(s[6 * 33], s[7 * 33]);
        *(u32x4*)(WT + (size_t)(n0 + n) * ldo + col_off + k0 + 8 * c) = o; }
    LDS_WAIT(); asm volatile("" ::: "memory");
}
__device__ __forceinline__ void rms_row_to_bf16(const float* xrow, const float* g, bf16_t* orow, int lane) {
    const f32x4* xr = (const f32x4*)xrow + lane; const f32x4* gr = (const f32x4*)g + lane;
    f32x4 v[4]; float s = 0.f;
#pragma unroll
    for (int j = 0; j < 4; ++j) { v[j] = xr[64 * j]; s += (v[j].x * v[j].x + v[j].y * v[j].y) + (v[j].z * v[j].z + v[j].w * v[j].w); }
    const float r = 1.0f / sqrtf(wave_sum(s) * (1.f / D) + EPS);
    u32x2* o8 = (u32x2*)orow + lane;
#pragma unroll
    for (int j = 0; j < 4; ++j) { const f32x4 gg = gr[64 * j]; u32x2 w; w.x = pk2(v[j].x * r * gg.x, v[j].y * r * gg.y); w.y = pk2(v[j].z * r * gg.z, v[j].w * r * gg.w); o8[64 * j] = w; }
}

struct Args {
    const float* x; const float* pre_g; const float* post_g; const float* w_in; const float* lq1; const float* lk1; const float* lq2; const float* lk2;
    const float* subln_g; const float* pool_w; const float* pool_b; const float* pool_scale; const float* sgu_ln_g; const float* sgu_ln_b; const float* sgu_w; const float* sgu_b;
    const float* w_branch; const float* w_merge; const float* b_merge; const float* w_out;
    float* out; unsigned char* ws; int ph_lo, ph_hi;
};

struct P0Args { const float* x; const float* pre_g; const float* w_in; const float* w_merge; const float* w_branch; const float* w_out; const float* pool_w; const float* sgu_w; unsigned char* ws; };
__device__ __forceinline__ void p0_prologue(const P0Args a, LAS unsigned char* lds, int vcu, int G) {
    const int tid = opaque_tid(), lane = tid & 63, wave = __builtin_amdgcn_readfirstlane(tid >> 6);
    LAS float* scr = (LAS float*)(lds + wave * 16384);
    const int gw = vcu * NWAVES + wave, NGW = G * NWAVES;
    bf16_t* WCAT = (bf16_t*)(a.ws + WS_WCAT); bf16_t* WB = (bf16_t*)(a.ws + WS_WB); bf16_t* WO = (bf16_t*)(a.ws + WS_WO); bf16_t* PW = (bf16_t*)(a.ws + WS_PW); bf16_t* SW = (bf16_t*)(a.ws + WS_SW);
    constexpr int I_IN = 16 * (INW / 32), I_MG = 16 * (GATEW / 32), I_BR = 8 * (D / 32), I_WO = 16 * (D / 32), I_PW = 2 * 4;
    constexpr int PER_L = I_IN + I_MG + 3 * I_BR + I_WO + 4 * I_PW;
    for (int it = gw; it < DEPTH * PER_L; it += NGW) {
        const int l = it / PER_L; int r = it % PER_L;
        if (r < I_IN) { p0_transpose_item(a.w_in + (size_t)l * D * INW, INW, WCAT + l * WCAT_L, 1024, 0, scr, r, lane); continue; } r -= I_IN;
        if (r < I_MG) { p0_transpose_item(a.w_merge + (size_t)l * D * GATEW, GATEW, WCAT + l * WCAT_L + (size_t)INW * 1024, 1024, 0, scr, r, lane); continue; } r -= I_MG;
        if (r < 3 * I_BR) { const int n = r / I_BR; p0_transpose_item(a.w_branch + ((size_t)l * 3 + n) * BW * D, D, WB + l * WB_L, 1536, n * 512, scr, r % I_BR, lane); continue; } r -= 3 * I_BR;
        if (r < I_WO) { p0_transpose_item(a.w_out + (size_t)l * D * D, D, WO + l * WO_L, 1024, 0, scr, r, lane); continue; } r -= I_WO;
        { const int g = r / I_PW; p0_transpose_item(a.pool_w + ((size_t)l * 4 + g) * 128 * 128, 128, PW + ((size_t)l * 4 + g) * 128 * 128, 128, 0, scr, r % I_PW, lane); }
    }
    for (int e = gw * 64 + lane; e < DEPTH * 4 * 128 * 128; e += NGW * 64) { const int j = e & 127, i = (e >> 7) & 127; const float v = a.sgu_w[e]; SW[e] = (bf16_t)f2bf(((j >> 6) <= (i >> 6)) ? v : 0.f); }
    bf16_t* H = (bf16_t*)(a.ws + WS_H);
    for (int m = gw; m < M; m += NGW) rms_row_to_bf16(a.x + (size_t)m * D, a.pre_g, H + (size_t)m * D, lane);
}

template <bool XIN_BF, bool XOUT_BF>
__device__ __forceinline__ void p5_rows(const void* xin_, const bf16_t* outb, const float* ssq, const float* post_g, const float* pre_g_next, void* xout_, bf16_t* H, int vcu, int G) {
    const int tid = opaque_tid(), lane = tid & 63, wave = __builtin_amdgcn_readfirstlane(tid >> 6);
    const int gw = vcu * NWAVES + wave, NGW = G * NWAVES;
    f32x4 pgv[4], grv[4];
#pragma unroll
    for (int j = 0; j < 4; ++j) { pgv[j] = ((const f32x4*)post_g + lane)[64 * j]; grv[j] = pre_g_next ? ((const f32x4*)pre_g_next + lane)[64 * j] : (f32x4){0.f, 0.f, 0.f, 0.f}; }
    for (int m0 = gw; m0 < M; m0 += 2 * NGW) {
        const int m1r = m0 + NGW; const bool has1 = m1r < M; const int m1 = has1 ? m1r : m0;
        f32x4 va[4], vb[4]; float sa = 0.f, sb2 = 0.f;
        { const f32x4* spa = (const f32x4*)(ssq + (size_t)m0 * 16); const f32x4* spb = (const f32x4*)(ssq + (size_t)m1 * 16);
          const f32x4 a0 = spa[0], a1 = spa[1], a2 = spa[2], a3 = spa[3], b0 = spb[0], b1 = spb[1], b2 = spb[2], b3 = spb[3];
          const float ssa = ((a0.x + a0.y) + (a0.z + a0.w)) + ((a1.x + a1.y) + (a1.z + a1.w)) + ((a2.x + a2.y) + (a2.z + a2.w)) + ((a3.x + a3.y) + (a3.z + a3.w));
          const float ssb = ((b0.x + b0.y) + (b0.z + b0.w)) + ((b1.x + b1.y) + (b1.z + b1.w)) + ((b2.x + b2.y) + (b2.z + b2.w)) + ((b3.x + b3.y) + (b3.z + b3.w));
          const float ra = 1.0f / sqrtf(ssa * (1.f / D) + EPS), rb = 1.0f / sqrtf(ssb * (1.f / D) + EPS);
          const u32x2* oa = (const u32x2*)(outb + (size_t)m0 * D) + lane; const u32x2* ob = (const u32x2*)(outb + (size_t)m1 * D) + lane;
#pragma unroll
          for (int j = 0; j < 4; ++j) { const f32x4 gv = pgv[j]; f32x4 xva, xvb;
              if (XIN_BF) { const u32x2 wa_ = ((const u32x2*)((const bf16_t*)xin_ + (size_t)m0 * D) + lane)[64 * j], wb_ = ((const u32x2*)((const bf16_t*)xin_ + (size_t)m1 * D) + lane)[64 * j];
                  xva = (f32x4){pg8::bflo(wa_.x), pg8::bfhi(wa_.x), pg8::bflo(wa_.y), pg8::bfhi(wa_.y)}; xvb = (f32x4){pg8::bflo(wb_.x), pg8::bfhi(wb_.x), pg8::bflo(wb_.y), pg8::bfhi(wb_.y)}; }
              else { xva = ((const f32x4*)((const float*)xin_ + (size_t)m0 * D) + lane)[64 * j]; xvb = ((const f32x4*)((const float*)xin_ + (size_t)m1 * D) + lane)[64 * j]; }
              const u32x2 owa = oa[64 * j], owb = ob[64 * j];
              const f32x4 ova = (f32x4){pg8::bflo(owa.x), pg8::bfhi(owa.x), pg8::bflo(owa.y), pg8::bfhi(owa.y)}, ovb = (f32x4){pg8::bflo(owb.x), pg8::bfhi(owb.x), pg8::bflo(owb.y), pg8::bfhi(owb.y)};
              va[j] = xva + ova * ra * gv; vb[j] = xvb + ovb * rb * gv;
              sa += (va[j].x * va[j].x + va[j].y * va[j].y) + (va[j].z * va[j].z + va[j].w * va[j].w); sb2 += (vb[j].x * vb[j].x + vb[j].y * vb[j].y) + (vb[j].z * vb[j].z + vb[j].w * vb[j].w); } }
        if (XOUT_BF) { u32x2* xoa = (u32x2*)((bf16_t*)xout_ + (size_t)m0 * D) + lane; u32x2* xob = (u32x2*)((bf16_t*)xout_ + (size_t)m1 * D) + lane;
#pragma unroll
            for (int j = 0; j < 4; ++j) { u32x2 wa_, wb_; wa_.x = pg8::cvt_pk_bf16(va[j].x, va[j].y); wa_.y = pg8::cvt_pk_bf16(va[j].z, va[j].w); wb_.x = pg8::cvt_pk_bf16(vb[j].x, vb[j].y); wb_.y = pg8::cvt_pk_bf16(vb[j].z, vb[j].w);
                xoa[64 * j] = wa_; if (has1) xob[64 * j] = wb_; } }
        else { f32x4* xoa = (f32x4*)((float*)xout_ + (size_t)m0 * D) + lane; f32x4* xob = (f32x4*)((float*)xout_ + (size_t)m1 * D) + lane;
#pragma unroll
            for (int j = 0; j < 4; ++j) { xoa[64 * j] = va[j]; if (has1) xob[64 * j] = vb[j]; } }
        if (pre_g_next) {
            const float r2a = 1.0f / sqrtf(wave_sum(sa) * (1.f / D) + EPS), r2b = 1.0f / sqrtf(wave_sum(sb2) * (1.f / D) + EPS);
            u32x2* o8a = (u32x2*)(H + (size_t)m0 * D) + lane; u32x2* o8b = (u32x2*)(H + (size_t)m1 * D) + lane;
#pragma unroll
            for (int j = 0; j < 4; ++j) { const f32x4 gg = grv[j]; u32x2 wa, wb; wa.x = pg8::cvt_pk_bf16(va[j].x * r2a * gg.x, va[j].y * r2a * gg.y); wa.y = pg8::cvt_pk_bf16(va[j].z * r2a * gg.z, va[j].w * r2a * gg.w);
                wb.x = pg8::cvt_pk_bf16(vb[j].x * r2b * gg.x, vb[j].y * r2b * gg.y); wb.y = pg8::cvt_pk_bf16(vb[j].z * r2b * gg.z, vb[j].w * r2b * gg.w); o8a[64 * j] = wa; if (has1) o8b[64 * j] = wb; }
        }
    }
}

#define MFMA16(a, b, c) __builtin_amdgcn_mfma_f32_16x16x32_bf16((a), (b), (c), 0, 0, 0)
constexpr int ASTG = 32768;
__device__ __forceinline__ bf16x8 pack8(const f32x4& a, const f32x4& b) {
    u32x4 w; w.x = pg8::cvt_pk_bf16(a[0], a[1]); w.y = pg8::cvt_pk_bf16(a[2], a[3]); w.z = pg8::cvt_pk_bf16(b[0], b[1]); w.w = pg8::cvt_pk_bf16(b[2], b[3]);
    return __builtin_bit_cast(bf16x8, w);
}
__device__ __forceinline__ float xmax32(float v) { auto rr = __builtin_amdgcn_permlane32_swap(__float_as_uint(v), __float_as_uint(v), false, false); return fmaxf(__uint_as_float(rr[0]), __uint_as_float(rr[1])); }
__device__ __forceinline__ float xmax16(float v) { auto rr = __builtin_amdgcn_permlane16_swap(__float_as_uint(v), __float_as_uint(v), false, false); return fmaxf(__uint_as_float(rr[0]), __uint_as_float(rr[1])); }
__device__ __forceinline__ void swap16x4(f32x4& a, f32x4& b) {
#pragma unroll
    for (int j = 0; j < 4; ++j) { auto r = __builtin_amdgcn_permlane16_swap(__float_as_uint(a[j]), __float_as_uint(b[j]), false, false); a[j] = __uint_as_float(r[0]); b[j] = __uint_as_float(r[1]); }
}
__device__ __forceinline__ void attn_unit(int b, int h, int qb, bf16_t* R1, const bf16_t* R2, const bf16_t* VT, const float* subln_g, float lam, float one_m_lam_init, LAS unsigned char* lds, bool do_store) {
    const int tid = opaque_tid(), lane = tid & 63, wid = __builtin_amdgcn_readfirstlane(tid >> 6), fr = lane & 15, fq = lane >> 4;
    const size_t tok0 = (size_t)b * SEQ;
    const int qrow = qb * 128 + wid * 16 + fr;
    bf16x8 qf[2][2];
    { const bf16_t* qp = R1 + (tok0 + qrow) * R1_LD + h * 128 + fq * 8;
#pragma unroll
      for (int m = 0; m < 2; ++m)
#pragma unroll
        for (int ks = 0; ks < 2; ++ks) qf[m][ks] = *(const bf16x8*)(qp + m * 64 + ks * 32); }
    const bf16_t* ksrc[2]; const bf16_t* vsrc[2];
#pragma unroll
    for (int i = 0; i < 2; ++i) { const int j = wid + 8 * i; const int kr = 4 * j + (lane >> 4), vr = 8 * j + (lane >> 3);
        ksrc[i] = R2 + (tok0 + kr) * R2_LD + h * 128 + (((lane & 15) ^ (kr & 15)) * 8);
        vsrc[i] = VT + ((size_t)((b * 4 + h) * 128 + vr)) * SEQ + (((lane & 7) ^ ((vr >> 1) & 7)) * 8); }
#define ATT_DMA(T_, stage) do { _Pragma("unroll") for (int u_ = 0; u_ < 2; ++u_) _Pragma("unroll") for (int i_ = 0; i_ < 2; ++i_) { \
        __builtin_amdgcn_global_load_lds((const unsigned*)(ksrc[i_] + (size_t)(2 * (T_) + u_) * 64 * R2_LD), (LAS unsigned*)(lds + (stage) * 65536 + u_ * ASTG + (wid + 8 * i_) * 1024), 16, 0, 0); \
        __builtin_amdgcn_global_load_lds((const unsigned*)(vsrc[i_] + (2 * (T_) + u_) * 64), (LAS unsigned*)(lds + (stage) * 65536 + u_ * ASTG + 16384 + (wid + 8 * i_) * 1024), 16, 0, 0); } } while (0)
    const int ND = qb + 1;
    if (wid >= 4) __builtin_amdgcn_s_setprio(1);
    ATT_DMA(0, 0);
    f32x4 o[2][8];
#pragma unroll
    for (int m = 0; m < 2; ++m)
#pragma unroll
        for (int nb = 0; nb < 8; ++nb) o[m][nb] = (f32x4){0.f, 0.f, 0.f, 0.f};
    float mrun[2] = {0.f, 0.f}, lrun[2] = {0.f, 0.f};
    int koff[2][2], voff[2];
#pragma unroll
    for (int m = 0; m < 2; ++m)
#pragma unroll
        for (int ks = 0; ks < 2; ++ks) koff[m][ks] = fr * 256 + (((m * 8 + ks * 4 + fq) ^ fr) * 16);
#pragma unroll
    for (int s2 = 0; s2 < 2; ++s2) voff[s2] = 16384 + fr * 128 + (((4 * s2 + fq) ^ ((fr >> 1) & 7)) * 16);
    asm volatile("s_waitcnt vmcnt(0)" ::: "memory"); __builtin_amdgcn_s_barrier(); asm volatile("" ::: "memory");
    for (int T = 0; T < ND; ++T) {
        const LAS unsigned char* sb = lds + (T & 1) * 65536;
        const bool skip2 = (T == ND - 1) && (wid < 4);
        bf16x8 pb[2][4];
#pragma unroll
        for (int m = 0; m < 2; ++m) {
            f32x4 s[2][4];
            const f32x4 negm = (f32x4){-mrun[m], -mrun[m], -mrun[m], -mrun[m]};
#define KFRAG(u_, j) (*(const LAS bf16x8*)(sb + (u_) * ASTG + ((j) >> 1) * 4096 + koff[m][(j) & 1]))
            __builtin_amdgcn_sched_barrier(0);
            { bf16x8 kf[4]; kf[0] = KFRAG(0, 0); kf[1] = KFRAG(0, 1); kf[2] = KFRAG(0, 2);
#pragma unroll
              for (int j = 0; j < 8; ++j) { const int kb = j >> 1, ks = j & 1;
                  if (j + 3 < 8) kf[(j + 3) & 3] = KFRAG(0, j + 3);
                  s[0][kb] = MFMA16(kf[j & 3], qf[m][ks], ks == 0 ? negm : s[0][kb]); }
              __builtin_amdgcn_sched_group_barrier(0x100, 3, 0);
#pragma unroll
              for (int j = 0; j < 5; ++j) { __builtin_amdgcn_sched_group_barrier(0x008, 1, 0); __builtin_amdgcn_sched_group_barrier(0x100, 1, 0); }
              __builtin_amdgcn_sched_group_barrier(0x008, 3, 0);
              __builtin_amdgcn_sched_barrier(0); }
            if (!skip2) {
                bf16x8 kf[4]; kf[0] = KFRAG(1, 0); kf[1] = KFRAG(1, 1); kf[2] = KFRAG(1, 2);
#pragma unroll
                for (int j = 0; j < 8; ++j) { const int kb = j >> 1, ks = j & 1;
                    if (j + 3 < 8) kf[(j + 3) & 3] = KFRAG(1, j + 3);
                    s[1][kb] = MFMA16(kf[j & 3], qf[m][ks], ks == 0 ? negm : s[1][kb]); }
                __builtin_amdgcn_sched_group_barrier(0x100, 3, 0);
#pragma unroll
                for (int j = 0; j < 5; ++j) { __builtin_amdgcn_sched_group_barrier(0x008, 1, 0); __builtin_amdgcn_sched_group_barrier(0x100, 1, 0); }
                __builtin_amdgcn_sched_group_barrier(0x008, 3, 0);
                __builtin_amdgcn_sched_barrier(0);
            } else {
#pragma unroll
                for (int kb = 0; kb < 4; ++kb) s[1][kb] = (f32x4){-1e30f, -1e30f, -1e30f, -1e30f};
            }
#undef KFRAG
            float mx = -1e30f;
#pragma unroll
            for (int u = 0; u < 2; ++u)
#pragma unroll
                for (int kb = 0; kb < 4; ++kb) { mx = __builtin_fmaxf(__builtin_fmaxf(mx, s[u][kb][0]), s[u][kb][1]); mx = __builtin_fmaxf(__builtin_fmaxf(mx, s[u][kb][2]), s[u][kb][3]); }
            mx = xmax16(mx); mx = xmax32(mx);
            if (T == 0 || __any(mx > 8.0f)) {
                const float dl = (T == 0) ? mx : fmaxf(mx, 0.f), f = __builtin_amdgcn_exp2f(-dl);
                mrun[m] += dl; lrun[m] *= f;
#pragma unroll
                for (int u = 0; u < 2; ++u)
#pragma unroll
                    for (int kb = 0; kb < 4; ++kb) s[u][kb] = s[u][kb] - dl;
#pragma unroll
                for (int nb = 0; nb < 8; ++nb) o[m][nb] = o[m][nb] * f;
            }
            float ps = 0.f;
#pragma unroll
            for (int u = 0; u < 2; ++u)
#pragma unroll
                for (int kb = 0; kb < 4; ++kb)
#pragma unroll
                    for (int j = 0; j < 4; ++j) { const float p = __builtin_amdgcn_exp2f(s[u][kb][j]); s[u][kb][j] = p; ps += p; }
            lrun[m] += ps;
#pragma unroll
            for (int u = 0; u < 2; ++u) { pb[m][2 * u] = pack8(s[u][0], s[u][1]); pb[m][2 * u + 1] = pack8(s[u][2], s[u][3]); }
        }
        if (T + 1 < ND) ATT_DMA(T + 1, (T + 1) & 1);
#pragma unroll
        for (int u = 0; u < 2; ++u) {
            if (u == 1 && skip2) continue;
            __builtin_amdgcn_sched_barrier(0);
            const LAS unsigned char* vb_ = sb + u * ASTG;
#define VFRAG(j) (*(const LAS bf16x8*)(vb_ + ((j) >> 1) * 2048 + voff[(j) & 1]))
            bf16x8 vf[4]; vf[0] = VFRAG(0); vf[1] = VFRAG(1); vf[2] = VFRAG(2);
#pragma unroll
            for (int j = 0; j < 16; ++j) { const int nb = j >> 1, s2 = j & 1;
                if (j + 3 < 16) vf[(j + 3) & 3] = VFRAG(j + 3);
                o[0][nb] = MFMA16(vf[j & 3], pb[0][2 * u + s2], o[0][nb]); o[1][nb] = MFMA16(vf[j & 3], pb[1][2 * u + s2], o[1][nb]);
            }
#undef VFRAG
            __builtin_amdgcn_sched_group_barrier(0x100, 3, 0);
#pragma unroll
            for (int j = 0; j < 13; ++j) { __builtin_amdgcn_sched_group_barrier(0x008, 2, 0); __builtin_amdgcn_sched_group_barrier(0x100, 1, 0); }
            __builtin_amdgcn_sched_group_barrier(0x008, 6, 0);
            __builtin_amdgcn_sched_barrier(0);
        }
        asm volatile("s_waitcnt vmcnt(0)" ::: "memory");
        __builtin_amdgcn_s_barrier(); asm volatile("" ::: "memory");
    }
#undef ATT_DMA
    __builtin_amdgcn_s_setprio(0);
    float l0 = lrun[0], l1 = lrun[1];
    l0 += __shfl_xor(l0, 16); l0 += __shfl_xor(l0, 32); l1 += __shfl_xor(l1, 16); l1 += __shfl_xor(l1, 32);
    const float i0 = 1.0f / l0, i1 = lam / l1;
    float ss = 0.f;
#pragma unroll
    for (int nb = 0; nb < 8; ++nb) { o[0][nb] = o[0][nb] * i0 - o[1][nb] * i1; ss += (o[0][nb][0] * o[0][nb][0] + o[0][nb][1] * o[0][nb][1]) + (o[0][nb][2] * o[0][nb][2] + o[0][nb][3] * o[0][nb][3]); }
    ss += __shfl_xor(ss, 16); ss += __shfl_xor(ss, 32);
    const float rr = one_m_lam_init / sqrtf(ss * (1.f / 128.f) + EPS);
    const int cst = 16 * (fq & 1) + 8 * (fq >> 1);
    const bf16_t* gap = R2 + (tok0 + qrow) * R2_LD + 512 + h * 128 + cst;
    bf16_t* yp = R1 + (tok0 + qrow) * R1_LD + h * 128 + cst;
#pragma unroll
    for (int p = 0; p < 4; ++p) { const u32x4 g4 = *(const u32x4*)(gap + p * 32);
        const f32x4 sa = *(const f32x4*)(subln_g + (2 * p) * 16 + fq * 4), sb = *(const f32x4*)(subln_g + (2 * p + 1) * 16 + fq * 4);
        f32x4 a = o[0][2 * p] * rr * sa, b = o[0][2 * p + 1] * rr * sb;
        swap16x4(a, b);
        u32x4 w; w.x = pg8::cvt_pk_bf16(a[0] * pg8::bflo(g4.x), a[1] * pg8::bfhi(g4.x)); w.y = pg8::cvt_pk_bf16(a[2] * pg8::bflo(g4.y), a[3] * pg8::bfhi(g4.y));
        w.z = pg8::cvt_pk_bf16(b[0] * pg8::bflo(g4.z), b[1] * pg8::bfhi(g4.z)); w.w = pg8::cvt_pk_bf16(b[2] * pg8::bflo(g4.w), b[3] * pg8::bfhi(g4.w));
        if (do_store) *(u32x4*)(yp + p * 32) = w; }
}

constexpr int MSTR = 272, MBUF = 128 * MSTR;
__device__ __forceinline__ void mix_gemm(const LAS unsigned char* la, const LAS unsigned char* lb, f32x4 (&acc)[4][2], int wr, int wc, int fr, int fq) {
#pragma unroll
    for (int mi = 0; mi < 4; ++mi)
#pragma unroll
        for (int ni = 0; ni < 2; ++ni) acc[mi][ni] = (f32x4){0.f, 0.f, 0.f, 0.f};
#pragma unroll
    for (int ks = 0; ks < 4; ++ks) {
        bf16x8 bfr[2], afr[4];
#pragma unroll
        for (int ni = 0; ni < 2; ++ni) bfr[ni] = *(const LAS bf16x8*)(lb + (wc * 32 + ni * 16 + fr) * MSTR + ks * 64 + fq * 16);
#pragma unroll
        for (int mi = 0; mi < 4; ++mi) afr[mi] = *(const LAS bf16x8*)(la + (wr * 64 + mi * 16 + fr) * MSTR + ks * 64 + fq * 16);
#pragma unroll
        for (int mi = 0; mi < 4; ++mi)
#pragma unroll
            for (int ni = 0; ni < 2; ++ni) acc[mi][ni] = MFMA16(bfr[ni], afr[mi], acc[mi][ni]);
    }
}

__device__ __forceinline__ void pool_unit(int tb, int g, bf16_t* R1, const bf16_t* R2, const bf16_t* PWl, const float* pool_b, const float* pool_scale, LAS unsigned char* lds, bool do_store) {
    const int tid = opaque_tid(), lane = tid & 63, wid = __builtin_amdgcn_readfirstlane(tid >> 6), fr = lane & 15, fq = lane >> 4, wr = wid >> 2, wc = wid & 3;
    LAS unsigned char* la = lds; LAS unsigned char* lb = lds + MBUF; LAS unsigned char* lp = lds + 2 * MBUF;
    const int W = 2 << g; const int t0 = tb * 128; const bool first = (t0 & (SEQ - 1)) == 0;
    const int cst = wc * 32 + 16 * (fq & 1) + 8 * (fq >> 1);
    u32x4 ggv[4]; f32x4 pbv[2], scv[2];
#pragma unroll
    for (int ni = 0; ni < 2; ++ni) { const int col = g * 128 + wc * 32 + ni * 16 + fq * 4; pbv[ni] = *(const f32x4*)(pool_b + col); scv[ni] = *(const f32x4*)(pool_scale + col); }
#pragma unroll
    for (int mi = 0; mi < 4; ++mi) ggv[mi] = *(const u32x4*)(R1 + (size_t)(tb * 128 + wr * 64 + mi * 16 + fr) * R1_LD + 512 + g * 128 + cst);
#pragma unroll
    for (int i = 0; i < 4; ++i) { const int p = tid + 512 * i, row = p >> 4, ch = p & 15;
        *(LAS u32x4*)(lb + row * MSTR + ch * 16) = *(const u32x4*)(PWl + (size_t)g * 128 * 128 + row * 128 + ch * 8); }
#pragma unroll
    for (int i = 0; i < 5; ++i) { const int p = tid + 512 * i, row = p >> 4, ch = p & 15;
        if (row < 143) { u32x4 v = (u32x4){0u, 0u, 0u, 0u}; if (!(first && row < 15)) v = *(const u32x4*)(R2 + (size_t)(t0 - 15 + row) * R2_LD + 1024 + g * 128 + ch * 8);
            *(LAS u32x4*)(lp + row * MSTR + ch * 16) = v; } }
    __syncthreads();
    { const int tg = tid >> 4, ch = tid & 15, T0 = 4 * tg; const int s0 = (t0 + T0) & (SEQ - 1);
      const LAS unsigned char* src = lp + (T0 + 15) * MSTR + ch * 16;
      float a[8];
#pragma unroll
      for (int e = 0; e < 8; ++e) a[e] = 0.f;
      u32x4 w = (u32x4){0u, 0u, 0u, 0u};
      for (int k = W - 1; k >= 0; --k) { w = *(const LAS u32x4*)(src - k * MSTR);
          a[0] += pg8::bflo(w.x); a[1] += pg8::bfhi(w.x); a[2] += pg8::bflo(w.y); a[3] += pg8::bfhi(w.y); a[4] += pg8::bflo(w.z); a[5] += pg8::bfhi(w.z); a[6] += pg8::bflo(w.w); a[7] += pg8::bfhi(w.w); }
#pragma unroll
      for (int d = 0; d < 4; ++d) {
          if (d > 0) { w = *(const LAS u32x4*)(src + d * MSTR); const u32x4 wo = *(const LAS u32x4*)(src + (d - W) * MSTR);
              a[0] += pg8::bflo(w.x) - pg8::bflo(wo.x); a[1] += pg8::bfhi(w.x) - pg8::bfhi(wo.x); a[2] += pg8::bflo(w.y) - pg8::bflo(wo.y); a[3] += pg8::bfhi(w.y) - pg8::bfhi(wo.y);
              a[4] += pg8::bflo(w.z) - pg8::bflo(wo.z); a[5] += pg8::bfhi(w.z) - pg8::bfhi(wo.z); a[6] += pg8::bflo(w.w) - pg8::bflo(wo.w); a[7] += pg8::bfhi(w.w) - pg8::bfhi(wo.w); }
          const int sd = s0 + d; const int cnt = (sd + 1 < W) ? (sd + 1) : W; const float ic = 1.0f / (float)cnt;
          u32x4 ov; ov.x = pg8::cvt_pk_bf16(a[0] * ic - pg8::bflo(w.x), a[1] * ic - pg8::bfhi(w.x)); ov.y = pg8::cvt_pk_bf16(a[2] * ic - pg8::bflo(w.y), a[3] * ic - pg8::bfhi(w.y));
          ov.z = pg8::cvt_pk_bf16(a[4] * ic - pg8::bflo(w.z), a[5] * ic - pg8::bfhi(w.z)); ov.w = pg8::cvt_pk_bf16(a[6] * ic - pg8::bflo(w.w), a[7] * ic - pg8::bfhi(w.w));
          *(LAS u32x4*)(la + (T0 + d) * MSTR + ch * 16) = ov; } }
    __syncthreads();
    f32x4 acc[4][2];
    mix_gemm(la, lb, acc, wr, wc, fr, fq);
#pragma unroll
    for (int mi = 0; mi < 4; ++mi) { const int t = tb * 128 + wr * 64 + mi * 16 + fr;
        f32x4 a = (acc[mi][0] + pbv[0]) * scv[0], b = (acc[mi][1] + pbv[1]) * scv[1];
        swap16x4(a, b);
        const u32x4 g4 = ggv[mi];
        u32x4 w; w.x = pg8::cvt_pk_bf16(a[0] * pg8::bflo(g4.x), a[1] * pg8::bfhi(g4.x)); w.y = pg8::cvt_pk_bf16(a[2] * pg8::bflo(g4.y), a[3] * pg8::bfhi(g4.y));
        w.z = pg8::cvt_pk_bf16(b[0] * pg8::bflo(g4.z), b[1] * pg8::bfhi(g4.z)); w.w = pg8::cvt_pk_bf16(b[2] * pg8::bflo(g4.w), b[3] * pg8::bfhi(g4.w));
        if (do_store) *(u32x4*)(R1 + (size_t)t * R1_LD + 512 + g * 128 + cst) = w; }
    __syncthreads();
}

__device__ __forceinline__ void sgu_unit(int tb, int g, bf16_t* R1, const bf16_t* R2, const bf16_t* SWl, const float* ln_g, const float* ln_b, const float* sgu_b, const f32x2* SVST, LAS unsigned char* lds, bool do_store) {
    const int tid = opaque_tid(), lane = tid & 63, wid = __builtin_amdgcn_readfirstlane(tid >> 6), fr = lane & 15, fq = lane >> 4, wr = wid >> 2, wc = wid & 3;
    LAS unsigned char* la = lds; LAS unsigned char* lb = lds + MBUF;
    const int cst = wc * 32 + 16 * (fq & 1) + 8 * (fq >> 1);
    u32x4 ggv[4], uuv[4]; float bsv[4];
#pragma unroll
    for (int mi = 0; mi < 4; ++mi) { const int ipos = wr * 64 + mi * 16 + fr; bsv[mi] = sgu_b[g * 128 + ipos]; const size_t t = (size_t)(tb * 128 + ipos);
        ggv[mi] = *(const u32x4*)(R1 + t * R1_LD + 1024 + g * 128 + cst); uuv[mi] = *(const u32x4*)(R2 + t * R2_LD + 1536 + g * 128 + cst); }
    LAS f32x2* st = (LAS f32x2*)(lds + 2 * MBUF);
    if (tid < 128) { const f32x4* sp = (const f32x4*)(SVST + (size_t)(tb * 128 + tid) * 8); const f32x4 a0 = sp[0], a1 = sp[1], a2 = sp[2], a3 = sp[3];
        const float m0 = ((a0.x + a0.z) + (a1.x + a1.z) + (a2.x + a2.z) + (a3.x + a3.z)) * (1.f / 512.f), q0 = ((a0.y + a0.w) + (a1.y + a1.w) + (a2.y + a2.w) + (a3.y + a3.w)) * (1.f / 512.f);
        st[tid] = (f32x2){m0, 1.0f / sqrtf(fmaxf(q0 - m0 * m0, 0.f) + EPS)}; }
#pragma unroll
    for (int i = 0; i < 4; ++i) { const int p = tid + 512 * i, row = p >> 4, ch = p & 15;
        *(LAS u32x4*)(la + row * MSTR + ch * 16) = *(const u32x4*)(SWl + (size_t)g * 128 * 128 + row * 128 + ch * 8); }
    u32x4 rw[2][2];
#pragma unroll
    for (int i = 0; i < 2; ++i) { const int ci = i * 8 + wid, tp = (ci & 3) * 16 + (lane & 15), ch = (ci >> 2) * 4 + (lane >> 4);
        const bf16_t* src = R2 + (size_t)(tb * 128 + 2 * tp) * R2_LD + 2048 + g * 128 + ch * 8;
        rw[i][0] = *(const u32x4*)src; rw[i][1] = *(const u32x4*)(src + R2_LD); }
    __syncthreads();
#pragma unroll
    for (int i = 0; i < 2; ++i) { const int ci = i * 8 + wid, tp = (ci & 3) * 16 + (lane & 15), ch = (ci >> 2) * 4 + (lane >> 4);
        const u32x4 w0 = rw[i][0], w1 = rw[i][1];
        const f32x2 ms0 = st[2 * tp], ms1 = st[2 * tp + 1];
        const f32x4 g0 = *(const f32x4*)(ln_g + g * 128 + ch * 8), g1 = *(const f32x4*)(ln_g + g * 128 + ch * 8 + 4), b0 = *(const f32x4*)(ln_b + g * 128 + ch * 8), b1 = *(const f32x4*)(ln_b + g * 128 + ch * 8 + 4);
        const float va[8] = {pg8::bflo(w0.x), pg8::bfhi(w0.x), pg8::bflo(w0.y), pg8::bfhi(w0.y), pg8::bflo(w0.z), pg8::bfhi(w0.z), pg8::bflo(w0.w), pg8::bfhi(w0.w)};
        const float vb[8] = {pg8::bflo(w1.x), pg8::bfhi(w1.x), pg8::bflo(w1.y), pg8::bfhi(w1.y), pg8::bflo(w1.z), pg8::bfhi(w1.z), pg8::bflo(w1.w), pg8::bfhi(w1.w)};
#pragma unroll
        for (int e = 0; e < 8; ++e) { const float gg = e < 4 ? g0[e & 3] : g1[e & 3], bb = e < 4 ? b0[e & 3] : b1[e & 3];
            *(LAS unsigned*)(lb + (ch * 8 + e) * MSTR + tp * 4) = pg8::cvt_pk_bf16((va[e] - ms0.x) * ms0.y * gg + bb, (vb[e] - ms1.x) * ms1.y * gg + bb); } }
    __syncthreads();
    f32x4 acc[4][2];
    mix_gemm(la, lb, acc, wr, wc, fr, fq);
#pragma unroll
    for (int mi = 0; mi < 4; ++mi) { const int ipos = wr * 64 + mi * 16 + fr, t = tb * 128 + ipos; const float bs = bsv[mi];
        f32x4 a = acc[mi][0] + bs, b = acc[mi][1] + bs;
        swap16x4(a, b);
        const u32x4 g4 = ggv[mi], u4 = uuv[mi];
        u32x4 w; w.x = pg8::cvt_pk_bf16(a[0] * pg8::bflo(u4.x) * pg8::bflo(g4.x), a[1] * pg8::bfhi(u4.x) * pg8::bfhi(g4.x)); w.y = pg8::cvt_pk_bf16(a[2] * pg8::bflo(u4.y) * pg8::bflo(g4.y), a[3] * pg8::bfhi(u4.y) * pg8::bfhi(g4.y));
        w.z = pg8::cvt_pk_bf16(b[0] * pg8::bflo(u4.z) * pg8::bflo(g4.z), b[1] * pg8::bfhi(u4.z) * pg8::bfhi(g4.z)); w.w = pg8::cvt_pk_bf16(b[2] * pg8::bflo(u4.w) * pg8::bflo(g4.w), b[3] * pg8::bfhi(u4.w) * pg8::bfhi(g4.w));
        if (do_store) *(u32x4*)(R1 + (size_t)t * R1_LD + 1024 + g * 128 + cst) = w; }
    __syncthreads();
}

#define RLX_AGENT __ATOMIC_RELAXED, __HIP_MEMORY_SCOPE_AGENT
#define XB_TMO      128
#define XB_XCNT(j)  (256  + 64 * (j))
#define XB_XSUB(j)  (1280 + 64 * (j))
#define XB_XGEN(j)  (2304 + 64 * (j))
#define XB_TOP      3328
#define XB_TOPGEN   3392
#define XCD_BAR_WORDS 3456
#define XB_SPIN_CAP (1u << 22)

__device__ __forceinline__ unsigned xb_ld(unsigned* p)              { return __hip_atomic_load(p, __ATOMIC_RELAXED, __HIP_MEMORY_SCOPE_AGENT); }
__device__ __forceinline__ unsigned xb_add(unsigned* p, unsigned v) { return __hip_atomic_fetch_add(p, v, __ATOMIC_RELAXED, __HIP_MEMORY_SCOPE_AGENT); }
__device__ __forceinline__ unsigned xb_xcc_id() { return (unsigned)__builtin_amdgcn_s_getreg((3 << 11) | 20) & 0xFu; }
#define XB_SPIN(cond, bar) do { unsigned _sp = 0; while (cond) { \
    if ((++_sp & 255u) == 0u) { if (xb_ld(&(bar)[XB_TMO])) break; if (_sp > XB_SPIN_CAP) { atomicAdd(&(bar)[XB_TMO], 1u); break; } } } } while (0)

struct XcdBarrier {
    unsigned* bar; unsigned x;
    volatile LAS unsigned* st;
};

__device__ __forceinline__ XcdBarrier xcd_barrier_post(unsigned* bar, volatile LAS unsigned* st) {
    XcdBarrier b; b.bar = bar; b.x = xb_xcc_id(); b.st = st;
    if (threadIdx.x == 0) (void)xb_add(&bar[XB_XCNT(b.x)], 1u);
    return b;
}
__device__ __forceinline__ void xcd_barrier_complete(unsigned* bar, unsigned x, unsigned& nloc, unsigned& nx) {
    const unsigned G = gridDim.x * gridDim.y * gridDim.z;
    unsigned sum, cnt, mine, sp = 0u;
    for (;;) {
        sum = 0u; cnt = 0u; mine = 0u;
#pragma unroll
        for (unsigned j = 0; j < 16; ++j) { const unsigned c = xb_ld(&bar[XB_XCNT(j)]); sum += c; cnt += (c > 0u) ? 1u : 0u; mine = (j == x) ? c : mine; }
        if (sum == G) break;
        __builtin_amdgcn_s_sleep(1);
        if ((++sp & 255u) == 0u) { if (xb_ld(&bar[XB_TMO])) break; if (sp > XB_SPIN_CAP) { atomicAdd(&bar[XB_TMO], 1u); break; } }
    }
    nloc = mine > 0u ? mine : 1u; nx = cnt > 0u ? cnt : 1u;
}

__device__ __forceinline__ void xcd_barrier(const XcdBarrier& b) {
    asm volatile("s_waitcnt vmcnt(0)" ::: "memory");
    __syncthreads();
    if (threadIdx.x == 0) {
        unsigned* bar = b.bar;
        __builtin_amdgcn_s_waitcnt(0);
        unsigned nloc = b.st[0], nx = b.st[1];
        if (nloc == 0u) { xcd_barrier_complete(bar, b.x, nloc, nx); b.st[0] = nloc; b.st[1] = nx; }
        const unsigned old = xb_add(&bar[XB_XSUB(b.x)], 1u);
        const unsigned gen = old / nloc;
        if (old + 1u == (gen + 1u) * nloc) {
            __builtin_amdgcn_fence(__ATOMIC_RELEASE, "agent");
            asm volatile("s_waitcnt vmcnt(0)" ::: "memory");
            const unsigned og = xb_add(&bar[XB_TOP], 1u);
            const unsigned tg = og / nx;
            if (og + 1u == (tg + 1u) * nx) xb_add(&bar[XB_TOPGEN], 1u);
            else XB_SPIN(xb_ld(&bar[XB_TOPGEN]) == tg, bar);
            __builtin_amdgcn_fence(__ATOMIC_ACQUIRE, "agent");
            xb_add(&bar[XB_XGEN(b.x)], 1u);
            asm volatile("s_waitcnt vmcnt(0)" ::: "memory");
        } else {
            XB_SPIN(xb_ld(&bar[XB_XGEN(b.x)]) == gen, bar);
            __builtin_amdgcn_fence(__ATOMIC_ACQUIRE, "agent");
            asm volatile("s_waitcnt vmcnt(0)" ::: "memory");
        }
    }
    __syncthreads();
}

constexpr int N_PHASES = 1 + 6 * DEPTH;
typedef const __attribute__((address_space(4))) Args* KArgs;
#define FRESH_ARGS() KArgs ap = (KArgs)__builtin_amdgcn_kernarg_segment_ptr(); asm volatile("" : "+s"(ap)); unsigned char* ws = ap->ws
__global__ void __launch_bounds__(NTHREADS, 2) hybrid_fwd(Args a_unused) {
    extern __shared__ __attribute__((aligned(16))) unsigned char lds_raw[];
    LAS unsigned char* lds = (LAS unsigned char*)lds_raw;
    cg::grid_group grid = cg::this_grid();
    int lo, hi; { FRESH_ARGS(); (void)ws; lo = ap->ph_lo; hi = ap->ph_hi; }
    if (threadIdx.x < 2) ((volatile LAS unsigned*)(lds + LDS_BYTES - 64))[threadIdx.x] = 0u;
    __syncthreads();
    if (lo < 0) grid.sync();
    XcdBarrier xbar; { FRESH_ARGS(); xbar = xcd_barrier_post((unsigned*)(ws + WS_CTL), (volatile LAS unsigned*)(lds + LDS_BYTES - 64)); }
#define GV() const int G = gridDim.x, bx = blockIdx.x; const int vcu = (G % 8 == 0) ? (bx % 8) * (G / 8) + bx / 8 : bx; (void)vcu; (void)bx
#define IN(k) (lo <= (k) && (k) < hi)
#ifdef SEAM2
#define SEAM(k) do { if (IN(k) && IN((k) + 1)) { xcd_barrier(xbar); xcd_barrier(xbar); } } while (0)
#else
#define SEAM(k) do { if (IN(k) && IN((k) + 1)) xcd_barrier(xbar); } while (0)
#endif

#ifndef SKIP_P0
    if (IN(0)) { FRESH_ARGS(); GV(); P0Args a{ap->x, ap->pre_g, ap->w_in, ap->w_merge, ap->w_branch, ap->w_out, ap->pool_w, ap->sgu_w, ws}; p0_prologue(a, lds, vcu, G); __syncthreads();
#ifdef REP_P0
        p0_prologue(a, lds, vcu, G); __syncthreads();
#endif
    }
#endif
    SEAM(0);
#pragma unroll 1
    for (int l = 0; l < DEPTH; ++l) {
        const int pb = 1 + 6 * l;
#ifndef SKIP_P1
        if (IN(pb)) { FRESH_ARGS(); GV();
            pg8::Gemm g{(bf16_t*)(ws + WS_H), (bf16_t*)(ws + WS_WCAT) + l * WCAT_L, 1024, 1024, 1024, 0}; pg8::StaticOrderH S; S.init(M, INW, G, bx);
            pg8::EpiZ E{(bf16_t*)(ws + WS_R1), (bf16_t*)(ws + WS_R2), (bf16_t*)(ws + WS_VT), (f32x2*)(ws + WS_SVST)};
#ifdef REP_P1
            pg8::gemm_phase<pg8::EpiZ, pg8::StaticOrderH, true, true>(lds, g, S, E);
#endif
            pg8::gemm_phase<pg8::EpiZ, pg8::StaticOrderH, true, true>(lds, g, S, E);
        }
#endif
        SEAM(pb);
#ifndef SKIP_P2
        if (IN(pb + 1)) { FRESH_ARGS(); GV();
            const int lane = opaque_tid() & 63;
            bf16_t* R1 = (bf16_t*)(ws + WS_R1); const bf16_t* R2 = (const bf16_t*)(ws + WS_R2); const bf16_t* VT = (const bf16_t*)(ws + WS_VT);
            float lam, omli;
            { const float a1 = wave_sum(ap->lq1[l * 64 + lane] * ap->lk1[l * 64 + lane]), a2 = wave_sum(ap->lq2[l * 64 + lane] * ap->lk2[l * 64 + lane]);
              const float li = 0.8f - 0.6f * __expf(-0.3f * (float)l); lam = __expf(a1) - __expf(a2) + li; omli = 1.0f - li; }
            const float* subln = ap->subln_g + l * 128;
#ifdef REP_ATT
            for (int rep = 0; rep < 2; ++rep) { const bool st = (rep == 1) ? (lo >= 0) : (lo < 0);
#else
            { const bool st = true;
#endif
            for (int pr = vcu; pr < 256; pr += G) { const int bh = pr >> 3, i = pr & 7;
                attn_unit(bh >> 2, bh & 3, 15 - i, R1, R2, VT, subln, lam, omli, lds, st);
                attn_unit(bh >> 2, bh & 3, i, R1, R2, VT, subln, lam, omli, lds, st); } }
            const bf16_t* PWl = (const bf16_t*)(ws + WS_PW) + (size_t)l * 4 * 128 * 128; const bf16_t* SWl = (const bf16_t*)(ws + WS_SW) + (size_t)l * 4 * 128 * 128;
#ifdef REP_MIX
            for (int rep = 0; rep < 2; ++rep) { const bool st = (rep == 1) ? (lo >= 0) : (lo < 0);
#else
            { const bool st = true;
#endif
            for (int u = vcu; u < 1024; u += G) { const int w_ = u & 511, rnd = w_ >> 8, vv = w_ & 255; const int tb = rnd * 64 + (vv >> 2), g = rnd ? 3 - (vv & 3) : (vv & 3);
                if (u < 512) pool_unit(tb, g, R1, R2, PWl, ap->pool_b + l * 512, ap->pool_scale + l * 512, lds, st);
                else sgu_unit(tb, g, R1, R2, SWl, ap->sgu_ln_g + l * 512, ap->sgu_ln_b + l * 512, ap->sgu_b + l * 512, (const f32x2*)(ws + WS_SVST), lds, st); } }
        }
#endif
        SEAM(pb + 1);
#ifndef SKIP_P25
        if (IN(pb + 2)) { FRESH_ARGS(); GV();
            pg8::Gemm g{(bf16_t*)(ws + WS_H), (bf16_t*)(ws + WS_WCAT) + l * WCAT_L + (size_t)INW * 1024, 1024, 1024, 1024, 0}; pg8::StaticOrder S; S.init(M, GATEW, G, bx);
            pg8::EpiGate E{(bf16_t*)(ws + WS_GATE), ap->b_merge + l * GATEW};
#ifdef REP_P25
            pg8::gemm_phase<pg8::EpiGate, pg8::StaticOrder, true, true>(lds, g, S, E);
#endif
            pg8::gemm_phase<pg8::EpiGate, pg8::StaticOrder, true, true>(lds, g, S, E);
        }
#endif
        SEAM(pb + 2);
#ifndef SKIP_P3
        if (IN(pb + 3)) { FRESH_ARGS(); GV();
            pg8::Gemm g{(bf16_t*)(ws + WS_R1), (bf16_t*)(ws + WS_WB) + l * WB_L, 1536, 1536, 512, 1024}; pg8::StaticOrder3 S; S.init(M, D, G, bx);
            pg8::EpiMerge E{(bf16_t*)(ws + WS_GATE), (bf16_t*)(ws + WS_H)};
#ifdef REP_P3
            pg8::gemm_phase<pg8::EpiMerge, pg8::StaticOrder3, true, true>(lds, g, S, E);
#endif
            pg8::gemm_phase<pg8::EpiMerge, pg8::StaticOrder3, true, true>(lds, g, S, E);
        }
#endif
        SEAM(pb + 3);
#ifndef SKIP_P4
        if (IN(pb + 4)) { FRESH_ARGS(); GV();
            pg8::Gemm g{(bf16_t*)(ws + WS_H), (bf16_t*)(ws + WS_WO) + l * WO_L, 1024, 1024, 1024, 0}; pg8::StaticOrder S; S.init(M, D, G, bx);
            pg8::EpiOut E{(bf16_t*)(ws + WS_OUT), (float*)(ws + WS_SSQ)};
#ifdef REP_P4
            pg8::gemm_phase<pg8::EpiOut, pg8::StaticOrder, true, true>(lds, g, S, E);
#endif
            pg8::gemm_phase<pg8::EpiOut, pg8::StaticOrder, true, true>(lds, g, S, E);
        }
#endif
        SEAM(pb + 4);
#ifndef SKIP_P5
        if (IN(pb + 5)) { FRESH_ARGS(); GV();
#ifdef REP_P5L0
            if (l == 0) p5_rows<false, true>(ap->x, (const bf16_t*)(ws + WS_OUT), (const float*)(ws + WS_SSQ), ap->post_g + l * D, ap->pre_g + (l + 1) * D, ws + WS_X1, (bf16_t*)(ws + WS_H), vcu, G);
#endif
            if (l + 1 < DEPTH) p5_rows<false, true>(ap->x, (const bf16_t*)(ws + WS_OUT), (const float*)(ws + WS_SSQ), ap->post_g + l * D, ap->pre_g + (l + 1) * D, ws + WS_X1, (bf16_t*)(ws + WS_H), vcu, G);
            else p5_rows<true, false>(ws + WS_X1, (const bf16_t*)(ws + WS_OUT), (const float*)(ws + WS_SSQ), ap->post_g + l * D, nullptr, ap->out, (bf16_t*)(ws + WS_H), vcu, G);
        }
#endif
        SEAM(pb + 5);
    }
#undef IN
#undef SEAM
}

#ifndef MK_N_LAUNCHES
#define MK_N_LAUNCHES 1
#endif
extern "C" void kernel_launch(void* const* d_in, const int* in_sizes, int n_in, void* d_out, int out_size, void* d_ws, size_t ws_size, hipStream_t stream) {
    static int grid = 0;
    if (grid == 0) {
        if (n_in != 20 || in_sizes[0] != M * D || out_size != M * D || ws_size < WS_END) { fprintf(stderr, "kernel_launch: unexpected shapes (n_in %d in0 %d out %d ws %zu)\n", n_in, n_in > 0 ? in_sizes[0] : -1, out_size, ws_size); grid = -1; return; }
        int dev = 0, cus = 0, per_cu = 0;
        hipGetDevice(&dev); hipDeviceGetAttribute(&cus, hipDeviceAttributeMultiprocessorCount, dev);
        if (hipFuncSetAttribute((const void*)hybrid_fwd, hipFuncAttributeMaxDynamicSharedMemorySize, LDS_BYTES) != hipSuccess) { fprintf(stderr, "kernel_launch: hipFuncSetAttribute failed\n"); grid = -1; return; }
        if (hipOccupancyMaxActiveBlocksPerMultiprocessor(&per_cu, (const void*)hybrid_fwd, NTHREADS, LDS_BYTES) != hipSuccess || per_cu < 1) { fprintf(stderr, "kernel_launch: occupancy query says %d\n", per_cu); per_cu = 1; }
        (void)hipGetLastError();
        grid = cus * (per_cu > 1 ? 1 : per_cu);
        fprintf(stderr, "kernel_launch: grid %d (cus %d, per_cu %d)\n", grid, cus, per_cu);
    }
    if (grid < 0) return;
    Args a{};
    const float* const* in = (const float* const*)d_in;
    a.x = in[0]; a.pre_g = in[1]; a.post_g = in[2]; a.w_in = in[3]; a.lq1 = in[4]; a.lk1 = in[5]; a.lq2 = in[6]; a.lk2 = in[7];
    a.subln_g = in[8]; a.pool_w = in[9]; a.pool_b = in[10]; a.pool_scale = in[11]; a.sgu_ln_g = in[12]; a.sgu_ln_b = in[13]; a.sgu_w = in[14]; a.sgu_b = in[15];
    a.w_branch = in[16]; a.w_merge = in[17]; a.b_merge = in[18]; a.w_out = in[19];
    a.out = (float*)d_out; a.ws = (unsigned char*)d_ws;
    if (hipMemsetAsync((unsigned char*)d_ws + WS_CTL, 0, XCD_BAR_WORDS * 4, stream) != hipSuccess) { fprintf(stderr, "kernel_launch: memset failed\n"); return; }
#if MK_N_LAUNCHES == 1
    a.ph_lo = 0; a.ph_hi = N_PHASES;
    void* args[] = {&a};
    hipError_t e = hipLaunchCooperativeKernel((const void*)hybrid_fwd, dim3(grid), dim3(NTHREADS), args, LDS_BYTES, stream);
    if (e != hipSuccess) fprintf(stderr, "cooperative launch failed: %s (grid %d)\n", hipGetErrorString(e), grid);
#else
    for (int p = 0; p < N_PHASES; ++p) { a.ph_lo = p; a.ph_hi = p + 1; hipLaunchKernelGGL(hybrid_fwd, dim3(grid), dim3(NTHREADS), LDS_BYTES, stream, a); }
#endif
}
```

```cpp
#include <hip/hip_runtime.h>
#include <hip/hip_cooperative_groups.h>
#include <cstdio>
#include <cstdint>
namespace cg = cooperative_groups;

__device__ __forceinline__ int opaque_tid() { int t = threadIdx.x; asm volatile("" : "+v"(t)); return t; }
namespace pg8 {
#define PG8_LAS __attribute__((address_space(3)))
typedef unsigned short bf16_t;
typedef short bf16x8 __attribute__((ext_vector_type(8)));
typedef short s16x4 __attribute__((ext_vector_type(4)));
typedef float f32x4 __attribute__((ext_vector_type(4)));
typedef float f32x2 __attribute__((ext_vector_type(2)));
typedef unsigned u32x4 __attribute__((ext_vector_type(4)));
typedef unsigned u32x2 __attribute__((ext_vector_type(2)));
constexpr int BM = 256, BK = 64, HALF = 128, HTB = HALF * BK * 2  , STAGE_BYTES = 8 * HTB, NXCD = 8, WGM = 8;

__host__ __device__ __forceinline__ int lds_byte(int r, int c) { const int st = (r >> 4) * 2 + (c >> 5), rr = r & 15, cc = c & 31, ob = rr * 64 + cc * 2; return st * 1024 + (ob ^ (((ob >> 9) & 1) << 5)); }
__host__ __device__ __forceinline__ void stage_rc(int b, int& R, int& C) { const int st = b / 1024, sb = b % 1024, swz = sb ^ (((sb >> 9) & 1) << 5); R = (st >> 1) * 16 + swz / 64; C = (st & 1) * 32 + (swz % 64) / 2; }
__host__ __device__ __forceinline__ int perm32(int rho) { const int n = rho >> 4, i = rho & 15; return 8 * (i >> 2) + 4 * n + (i & 3); }

struct Unit { int pm, pn, kz, half; };
struct Gemm { const bf16_t* A; const bf16_t* Bt; int lda, ldb, K, kzstep; };

struct StaticOrder {
    int nM, nN, nwg, G, c;
    __host__ __device__ void init(int M, int N, int G_, int c_) { nM = M / BM; nN = N / BM; nwg = nM * nN; G = G_; c = c_; }
    __host__ __device__ bool next(int i, Unit& u) const {
        const long L = (long)i * G + c; if (L >= nwg) return false;
        int wgid = (int)L; { const int q = nwg / NXCD, r = nwg % NXCD, xcd = wgid % NXCD, off = wgid / NXCD; wgid = (xcd < r ? xcd * (q + 1) : r * (q + 1) + (xcd - r) * q) + off; }
        const int nig = WGM * nN, gid = wgid / nig, fm = gid * WGM, gsz = (nM - fm) < WGM ? (nM - fm) : WGM;
        u.pm = fm + ((wgid % nig) % gsz); u.pn = (wgid % nig) / gsz; u.kz = 0; u.half = 0; return true;
    }
    __device__ __forceinline__ void a_ready(const Unit&) const {}
    __device__ __forceinline__ void done(const Unit&) const {}
};
struct StaticOrderH {
    StaticOrder so;
    __host__ __device__ void init(int M, int N, int G_, int c_) { so.init(M, N, G_, c_); }
    __host__ __device__ bool next(int i, Unit& u) const {
        const int full = so.nwg / so.G, rem = so.nwg - full * so.G;
        if (i == full && rem * 2 == so.G) { StaticOrder t = so; t.c = so.c >> 1; if (!t.next(i, u)) return false; u.half = 1 + (so.c & 1); return true; }
        return so.next(i, u);
    }
    __device__ __forceinline__ void a_ready(const Unit&) const {}
    __device__ __forceinline__ void done(const Unit&) const {}
};
struct StaticOrder3 {
    StaticOrder so;
    __host__ __device__ void init(int M, int N, int G_, int c_) { so.init(M, N, G_, c_); }
    __host__ __device__ bool next(int i, Unit& u) const { if (!so.next(i / 3, u)) return false; u.kz = i % 3; return true; }
    __device__ __forceinline__ void a_ready(const Unit&) const {}
    __device__ __forceinline__ void done(const Unit&) const {}
};

__device__ __forceinline__ unsigned cvt_pk_bf16(float lo, float hi) { unsigned r; asm volatile("v_cvt_pk_bf16_f32 %0, %1, %2" : "=v"(r) : "v"(lo), "v"(hi)); return r; }
__device__ __forceinline__ f32x2 gelu_pk(f32x2 v) {
    const f32x2 av = __builtin_elementwise_abs(v), d = av * 0.2316418882f + 1.0f;
    f32x2 t; t.x = __builtin_amdgcn_rcpf(d.x); t.y = __builtin_amdgcn_rcpf(d.y);
    f32x2 q = t * 0.5307027145f + (-0.7265760135f); q = q * t + 0.7107068705f; q = q * t + (-0.142248368f); q = q * t + 0.127414796f; q = q * t;
    const f32x2 s = (v * v) * (-0.72134752044f);
    f32x2 e; e.x = __builtin_amdgcn_exp2f(s.x); e.y = __builtin_amdgcn_exp2f(s.y);
    const f32x2 m = v * (q * e), r = v - m;
    f32x2 o; o.x = v.x < 0.f ? m.x : r.x; o.y = v.y < 0.f ? m.y : r.y; return o;
}
__device__ __forceinline__ float sigmoid_f(float x) { return __builtin_amdgcn_rcpf(1.0f + __builtin_amdgcn_exp2f(-1.4426950408889634f * x)); }
__device__ __forceinline__ float bf2f(unsigned short b) { return __uint_as_float(((unsigned)b) << 16); }
__device__ __forceinline__ float bflo(unsigned w) { return __uint_as_float(w << 16); }
__device__ __forceinline__ float bfhi(unsigned w) { return __uint_as_float(w & 0xffff0000u); }

template <class Epi, class Sched, bool ALIGN_EPI = false, bool SP2 = false>
__device__ __forceinline__ void gemm_phase(PG8_LAS unsigned char* lds, const Gemm g, const Sched& S, const Epi& E) {
    const int tid = opaque_tid(), wid = __builtin_amdgcn_readfirstlane(tid >> 6), lane = tid & 63, wr = wid >> 2, wc = wid & 3, fr = lane & 15, fq = lane >> 4;
    const int K = g.K, nt = K / BK;
    unsigned voffA[2], voffB[2];
#pragma unroll
    for (int i = 0; i < 2; ++i) { int R, C; stage_rc(tid * 16 + i * 8192, R, C); const int Rb = Epi::PERM ? ((R & ~31) + perm32(R & 31)) : R;
        voffA[i] = (unsigned)(R * g.lda + C) * 2u; voffB[i] = (unsigned)(Rb * g.ldb + C) * 2u; }
    const size_t kstep = (size_t)(BK * 2);
    const size_t hstepA = (size_t)HALF * g.lda * 2, hstepB = (size_t)HALF * g.ldb * 2;
    const size_t tstepA = 2 * hstepA, tstepB = 2 * hstepB;
    const unsigned ldsw = (unsigned)wid * 1024u;
    const int aoff = lds_byte(wr * 64 + fr, fq * 8), boff = lds_byte(wc * 32 + fr, fq * 8);
#define PG8_SA(b, h) (((b) * 2 + (h)) * HTB)
#define PG8_SB(b, h) ((4 + (b) * 2 + (h)) * HTB)
#define PG8_STAGE(bufoff, gbase, voff) do { _Pragma("unroll") for (int _i = 0; _i < 2; ++_i) \
        __builtin_amdgcn_global_load_lds((const unsigned*)((const char*)(gbase) + (voff)[_i]), (PG8_LAS unsigned*)(lds + (bufoff) + ldsw + _i * 8192), 16, 0, 0); } while (0)
#define PG8_LDA(dst, b, h) do { _Pragma("unroll") for (int m = 0; m < 4; ++m) _Pragma("unroll") for (int k = 0; k < 2; ++k) dst[m][k] = *(const PG8_LAS bf16x8*)(lds + PG8_SA(b, h) + aoff + m * 2048 + k * 1024); } while (0)
#define PG8_LDB(dst, b, h) do { _Pragma("unroll") for (int n = 0; n < 2; ++n) _Pragma("unroll") for (int k = 0; k < 2; ++k) dst[n][k] = *(const PG8_LAS bf16x8*)(lds + PG8_SB(b, h) + boff + n * 2048 + k * 1024); } while (0)
#define PG8_MMA(ai, bj, At, Bt) do { __builtin_amdgcn_s_setprio(1); _Pragma("unroll") for (int m = 0; m < 4; ++m) _Pragma("unroll") for (int n = 0; n < 2; ++n) _Pragma("unroll") for (int k = 0; k < 2; ++k) \
        acc[ai][bj][m][n] = __builtin_amdgcn_mfma_f32_16x16x32_bf16(Bt[n][k], At[m][k], acc[ai][bj][m][n], 0, 0, 0); __builtin_amdgcn_s_setprio(0); } while (0)
#define PG8_WAIT_V(n) asm volatile("s_waitcnt vmcnt(" #n ")" ::: "memory")
#define PG8_WAIT_L(n) asm volatile("s_waitcnt lgkmcnt(" #n ")" ::: "memory")
#define PG8_BAR __builtin_amdgcn_s_barrier()
#define PG8_SCHED __builtin_amdgcn_sched_barrier(0)
    Unit cur, nxt; int ui = 0;
    if (!S.next(0, cur)) return;
    f32x4 acc[2][2][4][2];
#pragma unroll
    for (int a = 0; a < 2; ++a)
#pragma unroll
        for (int b = 0; b < 2; ++b)
#pragma unroll
            for (int m = 0; m < 4; ++m)
#pragma unroll
                for (int n = 0; n < 2; ++n) acc[a][b][m][n] = (f32x4){0.f, 0.f, 0.f, 0.f};
    bf16x8 At[4][2], B0[2][2], B1[2][2];
    const char* cA = (const char*)g.A + (size_t)cur.pm * tstepA + (size_t)cur.kz * g.kzstep + (cur.half == 2 ? hstepA : (size_t)0); const char* cB = (const char*)g.Bt + (size_t)cur.pn * tstepB + (size_t)cur.kz * g.kzstep;
    S.a_ready(cur);
    if constexpr (SP2) {
        PG8_STAGE(PG8_SB(0, 0), cB, voffB); PG8_STAGE(PG8_SB(0, 1), cB + hstepB, voffB); PG8_STAGE(PG8_SA(0, 0), cA, voffA); PG8_STAGE(PG8_SA(0, 1), cA + hstepA, voffA);
        if (wr == 1) PG8_BAR;
        PG8_WAIT_V(2); PG8_BAR;
        PG8_STAGE(PG8_SB(1, 0), cB + kstep, voffB); PG8_STAGE(PG8_SA(1, 0), cA + kstep, voffA); PG8_STAGE(PG8_SB(1, 1), cB + hstepB + kstep, voffB);
        PG8_WAIT_V(6); PG8_BAR;
    } else {
        PG8_STAGE(PG8_SB(0, 0), cB, voffB); PG8_STAGE(PG8_SA(0, 0), cA, voffA); PG8_STAGE(PG8_SB(0, 1), cB + hstepB, voffB); PG8_STAGE(PG8_SA(0, 1), cA + hstepA, voffA);
        if (wr == 1) PG8_BAR;
        PG8_WAIT_V(4); PG8_BAR;
        PG8_STAGE(PG8_SB(1, 0), cB + kstep, voffB); PG8_STAGE(PG8_SA(1, 0), cA + kstep, voffA); PG8_STAGE(PG8_SB(1, 1), cB + hstepB + kstep, voffB);
        PG8_WAIT_V(6); PG8_BAR;
    }
    for (;;) {
        const bool has_next = S.next(ui + 1, nxt);
        const char* nA = has_next ? (const char*)g.A + (size_t)nxt.pm * tstepA + (size_t)nxt.kz * g.kzstep + (nxt.half == 2 ? hstepA : (size_t)0) : cA; const char* nB = has_next ? (const char*)g.Bt + (size_t)nxt.pn * tstepB + (size_t)nxt.kz * g.kzstep : cB;
        const bool whole = (cur.half == 0);
        for (int t = 0; t < nt; t += 2) {
            const bool last = (t == nt - 2);
            const char* a1 = cA + (size_t)(t + 1) * kstep;
            const char* a2 = last ? nA : cA + (size_t)(t + 2) * kstep; const char* b2 = last ? nB : cB + (size_t)(t + 2) * kstep;
            const char* a3 = a2 + kstep; const char* b3 = b2 + kstep;
            if (last && has_next) S.a_ready(nxt);
            if constexpr (SP2) {
            PG8_LDB(B0, 0, 0); PG8_LDB(B1, 0, 1); PG8_SCHED; PG8_LDA(At, 0, 0); PG8_STAGE(PG8_SA(1, 1), a1 + hstepA, voffA);
            PG8_WAIT_V(8); PG8_WAIT_L(0); PG8_BAR; PG8_MMA(0, 0, At, B0); PG8_MMA(0, 1, At, B1); PG8_BAR; PG8_SCHED;
            PG8_LDA(At, 0, 1); PG8_STAGE(PG8_SB(0, 0), b2, voffB); PG8_STAGE(PG8_SB(0, 1), b2 + hstepB, voffB); PG8_STAGE(PG8_SA(0, 0), a2, voffA);
            PG8_WAIT_V(8); PG8_WAIT_L(0); PG8_BAR; if (whole) { PG8_MMA(1, 0, At, B0); PG8_MMA(1, 1, At, B1); } PG8_BAR; PG8_SCHED;
            PG8_LDB(B0, 1, 0); PG8_LDB(B1, 1, 1); PG8_SCHED; PG8_LDA(At, 1, 0); PG8_STAGE(PG8_SA(0, 1), a2 + hstepA, voffA);
            PG8_WAIT_V(8); PG8_WAIT_L(0); PG8_BAR; PG8_MMA(0, 0, At, B0); PG8_MMA(0, 1, At, B1); PG8_BAR; PG8_SCHED;
            PG8_LDA(At, 1, 1); PG8_STAGE(PG8_SB(1, 0), b3, voffB); PG8_STAGE(PG8_SB(1, 1), b3 + hstepB, voffB); PG8_STAGE(PG8_SA(1, 0), a3, voffA);
            PG8_WAIT_V(8); PG8_WAIT_L(0); PG8_BAR; if (whole) { PG8_MMA(1, 0, At, B0); PG8_MMA(1, 1, At, B1); } PG8_BAR; PG8_SCHED;
            } else {
            PG8_LDB(B0, 0, 0); PG8_SCHED; PG8_LDA(At, 0, 0); PG8_STAGE(PG8_SA(1, 1), a1 + hstepA, voffA);
            PG8_WAIT_L(8); PG8_BAR; PG8_WAIT_L(0); PG8_MMA(0, 0, At, B0); PG8_BAR; PG8_SCHED;
            PG8_LDB(B1, 0, 1); PG8_STAGE(PG8_SB(0, 0), b2, voffB);
            PG8_BAR; PG8_WAIT_L(0); PG8_MMA(0, 1, At, B1); PG8_BAR;
            PG8_LDA(At, 0, 1); PG8_STAGE(PG8_SA(0, 0), a2, voffA);
            PG8_BAR; PG8_WAIT_L(0); PG8_MMA(1, 0, At, B0); PG8_BAR; PG8_SCHED;
            PG8_STAGE(PG8_SB(0, 1), b2 + hstepB, voffB);
            PG8_WAIT_V(6); PG8_BAR; PG8_MMA(1, 1, At, B1); PG8_BAR;
            PG8_LDB(B0, 1, 0); PG8_SCHED; PG8_LDA(At, 1, 0); PG8_STAGE(PG8_SA(0, 1), a2 + hstepA, voffA);
            PG8_WAIT_L(8); PG8_BAR; PG8_WAIT_L(0); PG8_MMA(0, 0, At, B0); PG8_BAR; PG8_SCHED;
            PG8_LDB(B1, 1, 1); PG8_STAGE(PG8_SB(1, 0), b3, voffB);
            PG8_BAR; PG8_WAIT_L(0); PG8_MMA(0, 1, At, B1); PG8_BAR;
            PG8_LDA(At, 1, 1); PG8_STAGE(PG8_SA(1, 0), a3, voffA);
            PG8_BAR; PG8_WAIT_L(0); PG8_MMA(1, 0, At, B0); PG8_BAR; PG8_SCHED;
            PG8_STAGE(PG8_SB(1, 1), b3 + hstepB, voffB);
            PG8_WAIT_V(6); PG8_BAR; PG8_MMA(1, 1, At, B1); PG8_BAR;
            }
        }
        if constexpr (ALIGN_EPI) { if (wr == 0) PG8_BAR; }
        if constexpr (!Epi::AFTER_DRAIN) { E(acc, cur, wr, wc, fr, fq); S.done(cur); }
        if (!has_next) break;
        if (!Epi::keep_acc(cur)) {
#pragma unroll
        for (int a = 0; a < 2; ++a)
#pragma unroll
            for (int b = 0; b < 2; ++b)
#pragma unroll
                for (int m = 0; m < 4; ++m)
#pragma unroll
                    for (int n = 0; n < 2; ++n) acc[a][b][m][n] = (f32x4){0.f, 0.f, 0.f, 0.f};
        }
        cur = nxt; cA = nA; cB = nB; ++ui;
        if constexpr (ALIGN_EPI) { if (wr == 1) PG8_BAR; }
    }
    PG8_WAIT_V(0);
    if constexpr (!ALIGN_EPI) { if (wr == 0) PG8_BAR; }
    PG8_BAR;
    if constexpr (Epi::AFTER_DRAIN) { E.fused(acc, cur, wr, wc, fr, fq, lds, wid, lane); S.done(cur); }
#undef PG8_SA
#undef PG8_SB
#undef PG8_STAGE
#undef PG8_LDA
#undef PG8_LDB
#undef PG8_MMA
#undef PG8_WAIT_V
#undef PG8_WAIT_L
#undef PG8_BAR
#undef PG8_SCHED
}

constexpr float QSCALE = 0.125f * 1.4426950408889634f;
__device__ __forceinline__ float act_apply1(float v, int act) { return v; }

__device__ __forceinline__ float dpp_xor1(float v) { return __uint_as_float((unsigned)__builtin_amdgcn_mov_dpp((int)__float_as_uint(v), 0xB1, 0xF, 0xF, true)); }
__device__ __forceinline__ float dpp_xor2(float v) { return __uint_as_float((unsigned)__builtin_amdgcn_mov_dpp((int)__float_as_uint(v), 0x4E, 0xF, 0xF, true)); }
__device__ __forceinline__ void quad_transpose(f32x4& r, int li) {
    const bool o1 = (li & 1) != 0, o2 = (li & 2) != 0;
#pragma unroll
    for (int t = 0; t < 2; ++t) { const float a = r[2 * t], b = r[2 * t + 1]; const float rcv = dpp_xor1(o1 ? a : b); r[2 * t] = o1 ? rcv : a; r[2 * t + 1] = o1 ? b : rcv; }
#pragma unroll
    for (int x = 0; x < 2; ++x) { const float a = r[x], b = r[x + 2]; const float rcv = dpp_xor2(o2 ? a : b); r[x] = o2 ? rcv : a; r[x + 2] = o2 ? b : rcv; }
}
struct EpiZ {
    static constexpr bool PERM = true, AFTER_DRAIN = false;
    static __device__ __forceinline__ bool keep_acc(const Unit&) { return false; }
    bf16_t* R1; bf16_t* R2; bf16_t* VT; f32x2* SVST;
    __device__ __forceinline__ void operator()(const f32x4 (&acc)[2][2][4][2], const Unit& u, int wr, int wc, int fr, int fq) const {
        const int kind = u.pn >> 1, half = u.pn & 1;
        const int row0 = u.pm * BM + (u.half == 2 ? HALF : 0) + wr * 64 + fr; const int nai = u.half ? 1 : 2;
        if (kind == 2) {
            const int rowb = u.pm * BM + (u.half == 2 ? HALF : 0) + wr * 64, q = fr >> 2, li = fr & 3;
#pragma unroll
            for (int ai = 0; ai < 2; ++ai) { if (ai >= nai) break;
#pragma unroll
                for (int mp = 0; mp < 2; ++mp) {
                    const int r = rowb + ai * HALF + mp * 32; const int b = r >> 11, sb = (r & 2047) + q * 8;
#pragma unroll
                    for (int bj = 0; bj < 2; ++bj) {
                        const int cv = half * 256 + bj * HALF + wc * 32 + 8 * fq; const int hh = cv >> 7, dv = cv & 127;
#pragma unroll
                        for (int n = 0; n < 2; ++n) {
                            f32x4 x = acc[ai][bj][2 * mp][n], y = acc[ai][bj][2 * mp + 1][n];
                            quad_transpose(x, li); quad_transpose(y, li);
                            u32x4 w; w.x = cvt_pk_bf16(x[0], x[1]); w.y = cvt_pk_bf16(x[2], x[3]); w.z = cvt_pk_bf16(y[0], y[1]); w.w = cvt_pk_bf16(y[2], y[3]);
                            *(u32x4*)(VT + ((size_t)((b * 4 + hh) * 128 + dv + 4 * n + li)) * 2048 + sb) = w;
                        }
                    }
                } }
            return;
        }
        int act = 0; float sc = 1.f; bf16_t* dst = R2; int ld = 2560, cb = 0;
        if (kind == 0) { dst = R1; ld = 1536; cb = 0; sc = QSCALE; }
        else if (kind == 1) { cb = 0; }
        else if (kind == 3) { cb = 512; act = 1; }
        else if (kind == 4) { cb = 1024; }
        else if (kind == 5) { dst = R1; ld = 1536; cb = 512; act = 1; }
        else if (kind == 6) { cb = 1536; act = 2; }
        else if (kind == 7) { cb = 2048; act = 2; }
        else { dst = R1; ld = 1536; cb = 1024; act = 1; }
        const int col0 = cb + half * 256 + wc * 32 + 8 * fq;
#pragma unroll
        for (int ai = 0; ai < 2; ++ai) { if (ai >= nai) break;
#pragma unroll
            for (int m = 0; m < 4; ++m) { bf16_t* rowp = dst + (size_t)(row0 + ai * HALF + m * 16) * ld + col0; float ssum = 0.f, ssq = 0.f;
#pragma unroll
                for (int bj = 0; bj < 2; ++bj) { f32x4 v0 = acc[ai][bj][m][0], v1 = acc[ai][bj][m][1];
                    if (act == 2) { f32x2 a = gelu_pk((f32x2){v0[0], v0[1]}), b = gelu_pk((f32x2){v0[2], v0[3]}), c = gelu_pk((f32x2){v1[0], v1[1]}), d = gelu_pk((f32x2){v1[2], v1[3]});
                        v0 = (f32x4){a.x, a.y, b.x, b.y}; v1 = (f32x4){c.x, c.y, d.x, d.y};
                        if (kind == 7) { ssum += ((v0[0] + v0[1]) + (v0[2] + v0[3])) + ((v1[0] + v1[1]) + (v1[2] + v1[3]));
                            ssq += ((v0[0] * v0[0] + v0[1] * v0[1]) + (v0[2] * v0[2] + v0[3] * v0[3])) + ((v1[0] * v1[0] + v1[1] * v1[1]) + (v1[2] * v1[2] + v1[3] * v1[3])); } }
                    else if (act == 1) {
#pragma unroll
                        for (int e = 0; e < 4; ++e) { v0[e] = v0[e] * sigmoid_f(v0[e]); v1[e] = v1[e] * sigmoid_f(v1[e]); } }
                    v0 = v0 * sc; v1 = v1 * sc; u32x4 w; w.x = cvt_pk_bf16(v0[0], v0[1]); w.y = cvt_pk_bf16(v0[2], v0[3]); w.z = cvt_pk_bf16(v1[0], v1[1]); w.w = cvt_pk_bf16(v1[2], v1[3]);
                    *(u32x4*)(rowp + bj * HALF) = w; }
                if (kind == 7) { ssum += __shfl_xor(ssum, 16); ssum += __shfl_xor(ssum, 32); ssq += __shfl_xor(ssq, 16); ssq += __shfl_xor(ssq, 32);
                    if (fq == 0) SVST[(size_t)(row0 + ai * HALF + m * 16) * 8 + half * 4 + wc] = (f32x2){ssum, ssq}; } } }
    }
};

__device__ __forceinline__ size_t gate_img(int pm, int pn, int wr, int wc, int fr, int fq) { return ((size_t)(pm * 12 + pn) * 8 + (wr * 4 + wc)) * 8192 + (size_t)(fq * 16 + fr) * 8; }
struct EpiGate {
    static constexpr bool PERM = true, AFTER_DRAIN = false;
    static __device__ __forceinline__ bool keep_acc(const Unit&) { return false; }
    bf16_t* O; const float* bias;
    __device__ __forceinline__ void operator()(const f32x4 (&acc)[2][2][4][2], const Unit& u, int wr, int wc, int fr, int fq) const {
        const int col0 = u.pn * BM + wc * 32 + 8 * fq;
        bf16_t* img = O + gate_img(u.pm, u.pn, wr, wc, fr, fq);
        f32x4 bv[2][2];
#pragma unroll
        for (int bj = 0; bj < 2; ++bj)
#pragma unroll
            for (int n = 0; n < 2; ++n) bv[bj][n] = *(const f32x4*)(bias + col0 + bj * HALF + 4 * n);
#pragma unroll
        for (int ai = 0; ai < 2; ++ai)
#pragma unroll
            for (int m = 0; m < 4; ++m)
#pragma unroll
                for (int bj = 0; bj < 2; ++bj) { f32x4 v0 = acc[ai][bj][m][0] + bv[bj][0], v1 = acc[ai][bj][m][1] + bv[bj][1];
#pragma unroll
                    for (int e = 0; e < 4; ++e) { v0[e] = fmaxf(sigmoid_f(v0[e]), 1e-18f); v1[e] = fmaxf(sigmoid_f(v1[e]), 1e-18f); }
                    u32x4 w; w.x = cvt_pk_bf16(v0[0], v0[1]); w.y = cvt_pk_bf16(v0[2], v0[3]); w.z = cvt_pk_bf16(v1[0], v1[1]); w.w = cvt_pk_bf16(v1[2], v1[3]);
                    *(u32x4*)(img + ((ai * 4 + m) * 2 + bj) * 512) = w; }
    }
};

struct EpiMerge {
    static constexpr bool PERM = true, AFTER_DRAIN = false;
    static __device__ __forceinline__ bool keep_acc(const Unit& u) { return u.kz < 2; }
    const bf16_t* G; bf16_t* O;
    __device__ __forceinline__ void operator()(f32x4 (&acc)[2][2][4][2], const Unit& u, int wr, int wc, int fr, int fq) const {
        const int row0 = u.pm * BM + wr * 64 + fr; const int col0 = u.pn * BM + wc * 32 + 8 * fq;
        if (u.kz < 2) {
        const bf16_t* ia = G + gate_img(u.pm, u.kz * 4 + u.pn, wr, wc, fr, fq); const bf16_t* ib = G + gate_img(u.pm, (u.kz + 1) * 4 + u.pn, wr, wc, fr, fq);
#pragma unroll
        for (int ai = 0; ai < 2; ++ai)
#pragma unroll
            for (int m = 0; m < 4; ++m) {
#pragma unroll
                for (int bj = 0; bj < 2; ++bj) { const int idx = ((ai * 4 + m) * 2 + bj) * 512; const u32x4 a = *(const u32x4*)(ia + idx), b = *(const u32x4*)(ib + idx);
                    f32x4 r0, r1;
                    r0[0] = bflo(a.x) * __builtin_amdgcn_rcpf(bflo(b.x)); r0[1] = bfhi(a.x) * __builtin_amdgcn_rcpf(bfhi(b.x));
                    r0[2] = bflo(a.y) * __builtin_amdgcn_rcpf(bflo(b.y)); r0[3] = bfhi(a.y) * __builtin_amdgcn_rcpf(bfhi(b.y));
                    r1[0] = bflo(a.z) * __builtin_amdgcn_rcpf(bflo(b.z)); r1[1] = bfhi(a.z) * __builtin_amdgcn_rcpf(bfhi(b.z));
                    r1[2] = bflo(a.w) * __builtin_amdgcn_rcpf(bflo(b.w)); r1[3] = bfhi(a.w) * __builtin_amdgcn_rcpf(bfhi(b.w));
                    acc[ai][bj][m][0] = acc[ai][bj][m][0] * r0; acc[ai][bj][m][1] = acc[ai][bj][m][1] * r1; }
                if (m == 3) asm volatile("" ::: "memory"); }
        } else {
        const bf16_t* ia = G + gate_img(u.pm, 8 + u.pn, wr, wc, fr, fq);
#pragma unroll
        for (int ai = 0; ai < 2; ++ai)
#pragma unroll
            for (int m = 0; m < 4; ++m) { const size_t r = (size_t)(row0 + ai * HALF + m * 16);
#pragma unroll
                for (int bj = 0; bj < 2; ++bj) { const u32x4 a = *(const u32x4*)(ia + ((ai * 4 + m) * 2 + bj) * 512);
                    f32x4 v0 = acc[ai][bj][m][0], v1 = acc[ai][bj][m][1];
                    v0[0] *= bflo(a.x); v0[1] *= bfhi(a.x); v0[2] *= bflo(a.y); v0[3] *= bfhi(a.y);
                    v1[0] *= bflo(a.z); v1[1] *= bfhi(a.z); v1[2] *= bflo(a.w); v1[3] *= bfhi(a.w);
                    u32x4 w; w.x = cvt_pk_bf16(v0[0], v0[1]); w.y = cvt_pk_bf16(v0[2], v0[3]); w.z = cvt_pk_bf16(v1[0], v1[1]); w.w = cvt_pk_bf16(v1[2], v1[3]);
                    *(u32x4*)(O + r * 1024 + col0 + bj * HALF) = w; } }
        }
    }
};

struct EpiOut {
    static constexpr bool PERM = true, AFTER_DRAIN = false;
    static __device__ __forceinline__ bool keep_acc(const Unit&) { return false; }
    bf16_t* O; float* ssq;
    __device__ __forceinline__ void operator()(const f32x4 (&acc)[2][2][4][2], const Unit& u, int wr, int wc, int fr, int fq) const {
        const int row0 = u.pm * BM + wr * 64 + fr; const int col0 = u.pn * BM + wc * 32 + 8 * fq;
#pragma unroll
        for (int ai = 0; ai < 2; ++ai)
#pragma unroll
            for (int m = 0; m < 4; ++m) { const size_t r = (size_t)(row0 + ai * HALF + m * 16); float s = 0.f;
#pragma unroll
                for (int bj = 0; bj < 2; ++bj) { const f32x4 v0 = acc[ai][bj][m][0], v1 = acc[ai][bj][m][1];
                    s += (v0[0] * v0[0] + v0[1] * v0[1]) + (v0[2] * v0[2] + v0[3] * v0[3]) + (v1[0] * v1[0] + v1[1] * v1[1]) + (v1[2] * v1[2] + v1[3] * v1[3]);
                    u32x4 w; w.x = cvt_pk_bf16(v0[0], v0[1]); w.y = cvt_pk_bf16(v0[2], v0[3]); w.z = cvt_pk_bf16(v1[0], v1[1]); w.w = cvt_pk_bf16(v1[2], v1[3]);
                    *(u32x4*)(O + r * 1024 + col0 + bj * HALF) = w; }
                s += __shfl_xor(s, 16); s += __shfl_xor(s, 32);
                if (fq == 0) ssq[r * 16 + u.pn * 4 + wc] = s; }
    }
};
}

using pg8::bf16_t; using pg8::bf16x8; using pg8::s16x4; using pg8::f32x4; using pg8::f32x2; using pg8::u32x4; using pg8::u32x2;
#define LAS __attribute__((address_space(3)))
constexpr int NWAVES = 8, NTHREADS = 512;
constexpr int BATCH = 8, SEQ = 2048, D = 1024, M = BATCH * SEQ, DEPTH = 2, INW = 4608, GATEW = 3072, BW = 512;
constexpr int R1_LD = 1536, R2_LD = 2560;
constexpr float EPS = 1e-6f;
constexpr size_t MiB = 1u << 20;
constexpr size_t WS_WCAT = 0;
constexpr size_t WCAT_L = (size_t)7680 * 1024;
constexpr size_t WS_WB = 32 * MiB;
constexpr size_t WB_L = (size_t)1024 * 1536;
constexpr size_t WS_WO = 40 * MiB;
constexpr size_t WO_L = (size_t)1024 * 1024;
constexpr size_t WS_PW = 44 * MiB;
constexpr size_t WS_SW = 44 * MiB + 512 * 1024;
constexpr size_t WS_H = 48 * MiB;
constexpr size_t WS_R1 = 80 * MiB;
constexpr size_t WS_R2 = 128 * MiB;
constexpr size_t WS_VT = 208 * MiB;
constexpr size_t WS_GATE = 128 * MiB;
constexpr size_t WS_OUT = 128 * MiB;
constexpr size_t WS_SSQ = 39 * MiB;
constexpr size_t WS_SVST = 45 * MiB;
constexpr size_t WS_CTL = 46 * MiB;
constexpr size_t WS_X1 = 224 * MiB;
constexpr size_t WS_END = 256 * MiB;
constexpr int LDS_BYTES = 132 * 1024;

__device__ __forceinline__ float wave_sum(float v) {
#pragma unroll
    for (int o = 1; o < 64; o <<= 1) v += __shfl_xor(v, o);
    return v;
}
__device__ __forceinline__ unsigned f2bf(float f) { unsigned u = __builtin_bit_cast(unsigned, f); return (u + 0x7fffu + ((u >> 16) & 1u)) >> 16; }
__device__ __forceinline__ unsigned pk2(float lo, float hi) { return f2bf(lo) | (f2bf(hi) << 16); }
#define LDS_WAIT() asm volatile("s_waitcnt lgkmcnt(0)" ::: "memory")

__device__ __forceinline__ void p0_transpose_item(const float* W, int N, bf16_t* WT, int ldo, int col_off, LAS float* scr, int item, int lane) {
    const int nblk = N / 32, kb = item / nblk, nb = item % nblk, k0 = 64 * kb, n0 = 32 * nb;
    float wv[32];
#pragma unroll
    for (int i = 0; i < 32; ++i) { const int kk = 2 * i + (lane >> 5); wv[i] = W[(size_t)(k0 + kk) * N + n0 + (lane & 31)]; }
#pragma unroll
    for (int i = 0; i < 32; ++i) { const int kk = 2 * i + (lane >> 5); scr[kk * 33 + (lane & 31)] = wv[i]; }
    LDS_WAIT(); asm volatile("" ::: "memory");
    const int c = lane & 7;
#pragma unroll
    for (int j = 0; j < 4; ++j) { const int n = (lane >> 3) + 8 * j; const LAS float* s = scr + (8 * c) * 33 + n;
        u32x4 o; o.x = pk2(s[0 * 33], s[1 * 33]); o.y = pk2(s[2 * 33], s[3 * 33]); o.z = pk2(s[4 * 33], s[5 * 33]); o.w = pk2(s[6 * 33], s[7 * 33]);
        *(u32x4*)(WT + (size_t)(n0 + n) * ldo + col_off + k0 + 8 * c) = o; }
    LDS_WAIT(); asm volatile("" ::: "memory");
}
__device__ __forceinline__ void rms_row_to_bf16(const float* xrow, const float* g, bf16_t* orow, int lane) {
    const f32x4* xr = (const f32x4*)xrow + lane; const f32x4* gr = (const f32x4*)g + lane;
    f32x4 v[4]; float s = 0.f;
#pragma unroll
    for (int j = 0; j < 4; ++j) { v[j] = xr[64 * j]; s += (v[j].x * v[j].x + v[j].y * v[j].y) + (v[j].z * v[j].z + v[j].w * v[j].w); }
    const float r = 1.0f / sqrtf(wave_sum(s) * (1.f / D) + EPS);
    u32x2* o8 = (u32x2*)orow + lane;
#pragma unroll
    for (int j = 0; j < 4; ++j) { const f32x4 gg = gr[64 * j]; u32x2 w; w.x = pk2(v[j].x * r * gg.x, v[j].y * r * gg.y); w.y = pk2(v[j].z * r * gg.z, v[j].w * r * gg.w); o8[64 * j] = w; }
}

struct Args {
    const float* x; const float* pre_g; const float* post_g; const float* w_in; const float* lq1; const float* lk1; const float* lq2; const float* lk2;
    const float* subln_g; const float* pool_w; const float* pool_b; const float* pool_scale; const float* sgu_ln_g; const float* sgu_ln_b; const float* sgu_w; const float* sgu_b;
    const float* w_branch; const float* w_merge; const float* b_merge; const float* w_out;
    float* out; unsigned char* ws; int ph_lo, ph_hi;
};

struct P0Args { const float* x; const float* pre_g; const float* w_in; const float* w_merge; const float* w_branch; const float* w_out; const float* pool_w; const float* sgu_w; unsigned char* ws; };
__device__ __forceinline__ void p0_prologue(const P0Args a, LAS unsigned char* lds, int vcu, int G) {
    const int tid = opaque_tid(), lane = tid & 63, wave = __builtin_amdgcn_readfirstlane(tid >> 6);
    LAS float* scr = (LAS float*)(lds + wave * 16384);
    const int gw = vcu * NWAVES + wave, NGW = G * NWAVES;
    bf16_t* WCAT = (bf16_t*)(a.ws + WS_WCAT); bf16_t* WB = (bf16_t*)(a.ws + WS_WB); bf16_t* WO = (bf16_t*)(a.ws + WS_WO); bf16_t* PW = (bf16_t*)(a.ws + WS_PW); bf16_t* SW = (bf16_t*)(a.ws + WS_SW);
    constexpr int I_IN = 16 * (INW / 32), I_MG = 16 * (GATEW / 32), I_BR = 8 * (D / 32), I_WO = 16 * (D / 32), I_PW = 2 * 4;
    constexpr int PER_L = I_IN + I_MG + 3 * I_BR + I_WO + 4 * I_PW;
    for (int it = gw; it < DEPTH * PER_L; it += NGW) {
        const int l = it / PER_L; int r = it % PER_L;
        if (r < I_IN) { p0_transpose_item(a.w_in + (size_t)l * D * INW, INW, WCAT + l * WCAT_L, 1024, 0, scr, r, lane); continue; } r -= I_IN;
        if (r < I_MG) { p0_transpose_item(a.w_merge + (size_t)l * D * GATEW, GATEW, WCAT + l * WCAT_L + (size_t)INW * 1024, 1024, 0, scr, r, lane); continue; } r -= I_MG;
        if (r < 3 * I_BR) { const int n = r / I_BR; p0_transpose_item(a.w_branch + ((size_t)l * 3 + n) * BW * D, D, WB + l * WB_L, 1536, n * 512, scr, r % I_BR, lane); continue; } r -= 3 * I_BR;
        if (r < I_WO) { p0_transpose_item(a.w_out + (size_t)l * D * D, D, WO + l * WO_L, 1024, 0, scr, r, lane); continue; } r -= I_WO;
        { const int g = r / I_PW; p0_transpose_item(a.pool_w + ((size_t)l * 4 + g) * 128 * 128, 128, PW + ((size_t)l * 4 + g) * 128 * 128, 128, 0, scr, r % I_PW, lane); }
    }
    for (int e = gw * 64 + lane; e < DEPTH * 4 * 128 * 128; e += NGW * 64) { const int j = e & 127, i = (e >> 7) & 127; const float v = a.sgu_w[e]; SW[e] = (bf16_t)f2bf(((j >> 6) <= (i >> 6)) ? v : 0.f); }
    bf16_t* H = (bf16_t*)(a.ws + WS_H);
    for (int m = gw; m < M; m += NGW) rms_row_to_bf16(a.x + (size_t)m * D, a.pre_g, H + (size_t)m * D, lane);
}

template <bool XIN_BF, bool XOUT_BF>
__device__ __forceinline__ void p5_rows(const void* xin_, const bf16_t* outb, const float* ssq, const float* post_g, const float* pre_g_next, void* xout_, bf16_t* H, int vcu, int G) {
    const int tid = opaque_tid(), lane = tid & 63, wave = __builtin_amdgcn_readfirstlane(tid >> 6);
    const int gw = vcu * NWAVES + wave, NGW = G * NWAVES;
    f32x4 pgv[4], grv[4];
#pragma unroll
    for (int j = 0; j < 4; ++j) { pgv[j] = ((const f32x4*)post_g + lane)[64 * j]; grv[j] = pre_g_next ? ((const f32x4*)pre_g_next + lane)[64 * j] : (f32x4){0.f, 0.f, 0.f, 0.f}; }
    for (int m0 = gw; m0 < M; m0 += 2 * NGW) {
        const int m1r = m0 + NGW; const bool has1 = m1r < M; const int m1 = has1 ? m1r : m0;
        f32x4 va[4], vb[4]; float sa = 0.f, sb2 = 0.f;
        { const f32x4* spa = (const f32x4*)(ssq + (size_t)m0 * 16); const f32x4* spb = (const f32x4*)(ssq + (size_t)m1 * 16);
          const f32x4 a0 = spa[0], a1 = spa[1], a2 = spa[2], a3 = spa[3], b0 = spb[0], b1 = spb[1], b2 = spb[2], b3 = spb[3];
          const float ssa = ((a0.x + a0.y) + (a0.z + a0.w)) + ((a1.x + a1.y) + (a1.z + a1.w)) + ((a2.x + a2.y) + (a2.z + a2.w)) + ((a3.x + a3.y) + (a3.z + a3.w));
          const float ssb = ((b0.x + b0.y) + (b0.z + b0.w)) + ((b1.x + b1.y) + (b1.z + b1.w)) + ((b2.x + b2.y) + (b2.z + b2.w)) + ((b3.x + b3.y) + (b3.z + b3.w));
          const float ra = 1.0f / sqrtf(ssa * (1.f / D) + EPS), rb = 1.0f / sqrtf(ssb * (1.f / D) + EPS);
          const u32x2* oa = (const u32x2*)(outb + (size_t)m0 * D) + lane; const u32x2* ob = (const u32x2*)(outb + (size_t)m1 * D) + lane;
#pragma unroll
          for (int j = 0; j < 4; ++j) { const f32x4 gv = pgv[j]; f32x4 xva, xvb;
              if (XIN_BF) { const u32x2 wa_ = ((const u32x2*)((const bf16_t*)xin_ + (size_t)m0 * D) + lane)[64 * j], wb_ = ((const u32x2*)((const bf16_t*)xin_ + (size_t)m1 * D) + lane)[64 * j];
                  xva = (f32x4){pg8::bflo(wa_.x), pg8::bfhi(wa_.x), pg8::bflo(wa_.y), pg8::bfhi(wa_.y)}; xvb = (f32x4){pg8::bflo(wb_.x), pg8::bfhi(wb_.x), pg8::bflo(wb_.y), pg8::bfhi(wb_.y)}; }
              else { xva = ((const f32x4*)((const float*)xin_ + (size_t)m0 * D) + lane)[64 * j]; xvb = ((const f32x4*)((const float*)xin_ + (size_t)m1 * D) + lane)[64 * j]; }
              const u32x2 owa = oa[64 * j], owb = ob[64 * j];
              const f32x4 ova = (f32x4){pg8::bflo(owa.x), pg8::bfhi(owa.x), pg8::bflo(owa.y), pg8::bfhi(owa.y)}, ovb = (f32x4){pg8::bflo(owb.x), pg8::bfhi(owb.x), pg8::bflo(owb.y), pg8::bfhi(owb.y)};
              va[j] = xva + ova * ra * gv; vb[j] = xvb + ovb * rb * gv;
              sa += (va[j].x * va[j].x + va[j].y * va[j].y) + (va[j].z * va[j].z + va[j].w * va[j].w); sb2 += (vb[j].x * vb[j].x + vb[j].y * vb[j].y) + (vb[j].z * vb[j].z + vb[j].w * vb[j].w); } }
        if (XOUT_BF) { u32x2* xoa = (u32x2*)((bf16_t*)xout_ + (size_t)m0 * D) + lane; u32x2* xob = (u32x2*)((bf16_t*)xout_ + (size_t)m1 * D) + lane;
#pragma unroll
            for (int j = 0; j < 4; ++j) { u32x2 wa_, wb_; wa_.x = pg8::cvt_pk_bf16(va[j].x, va[j].y); wa_.y = pg8::cvt_pk_bf16(va[j].z, va[j].w); wb_.x = pg8::cvt_pk_bf16(vb[j].x, vb[j].y); wb_.y = pg8::cvt_pk_bf16(vb[j].z, vb[j].w);
                xoa[64 * j] = wa_; if (has1) xob[64 * j] = wb_; } }
        else { f32x4* xoa = (f32x4*)((float*)xout_ + (size_t)m0 * D) + lane; f32x4* xob = (f32x4*)((float*)xout_ + (size_t)m1 * D) + lane;
#pragma unroll
            for (int j = 0; j < 4; ++j) { xoa[64 * j] = va[j]; if (has1) xob[64 * j] = vb[j]; } }
        if (pre_g_next) {
            const float r2a = 1.0f / sqrtf(wave_sum(sa) * (1.f / D) + EPS), r2b = 1.0f / sqrtf(wave_sum(sb2) * (1.f / D) + EPS);
            u32x2* o8a = (u32x2*)(H + (size_t)m0 * D) + lane; u32x2* o8b = (u32x2*)(H + (size_t)m1 * D) + lane;
#pragma unroll
            for (int j = 0; j < 4; ++j) { const f32x4 gg = grv[j]; u32x2 wa, wb; wa.x = pg8::cvt_pk_bf16(va[j].x * r2a * gg.x, va[j].y * r2a * gg.y); wa.y = pg8::cvt_pk_bf16(va[j].z * r2a * gg.z, va[j].w * r2a * gg.w);
                wb.x = pg8::cvt_pk_bf16(vb[j].x * r2b * gg.x, vb[j].y * r2b * gg.y); wb.y = pg8::cvt_pk_bf16(vb[j].z * r2b * gg.z, vb[j].w * r2b * gg.w); o8a[64 * j] = wa; if (has1) o8b[64 * j] = wb; }
        }
    }
}

#define MFMA16(a, b, c) __builtin_amdgcn_mfma_f32_16x16x32_bf16((a), (b), (c), 0, 0, 0)
constexpr int ASTG = 32768;
__device__ __forceinline__ bf16x8 pack8(const f32x4& a, const f32x4& b) {
    u32x4 w; w.x = pg8::cvt_pk_bf16(a[0], a[1]); w.y = pg8::cvt_pk_bf16(a[2], a[3]); w.z = pg8::cvt_pk_bf16(b[0], b[1]); w.w = pg8::cvt_pk_bf16(b[2], b[3]);
    return __builtin_bit_cast(bf16x8, w);
}
__device__ __forceinline__ float xmax32(float v) { auto rr = __builtin_amdgcn_permlane32_swap(__float_as_uint(v), __float_as_uint(v), false, false); return fmaxf(__uint_as_float(rr[0]), __uint_as_float(rr[1])); }
__device__ __forceinline__ float xmax16(float v) { auto rr = __builtin_amdgcn_permlane16_swap(__float_as_uint(v), __float_as_uint(v), false, false); return fmaxf(__uint_as_float(rr[0]), __uint_as_float(rr[1])); }
__device__ __forceinline__ void swap16x4(f32x4& a, f32x4& b) {
#pragma unroll
    for (int j = 0; j < 4; ++j) { auto r = __builtin_amdgcn_permlane16_swap(__float_as_uint(a[j]), __float_as_uint(b[j]), false, false); a[j] = __uint_as_float(r[0]); b[j] = __uint_as_float(r[1]); }
}
__device__ __forceinline__ void attn_unit(int b, int h, int qb, bf16_t* R1, const bf16_t* R2, const bf16_t* VT, const float* subln_g, float lam, float one_m_lam_init, LAS unsigned char* lds, bool do_store) {
    const int tid = opaque_tid(), lane = tid & 63, wid = __builtin_amdgcn_readfirstlane(tid >> 6), fr = lane & 15, fq = lane >> 4;
    const size_t tok0 = (size_t)b * SEQ;
    const int qrow = qb * 128 + wid * 16 + fr;
    bf16x8 qf[2][2];
    { const bf16_t* qp = R1 + (tok0 + qrow) * R1_LD + h * 128 + fq * 8;
#pragma unroll
      for (int m = 0; m < 2; ++m)
#pragma unroll
        for (int ks = 0; ks < 2; ++ks) qf[m][ks] = *(const bf16x8*)(qp + m * 64 + ks * 32); }
    const bf16_t* ksrc[2]; const bf16_t* vsrc[2];
#pragma unroll
    for (int i = 0; i < 2; ++i) { const int j = wid + 8 * i; const int kr = 4 * j + (lane >> 4), vr = 8 * j + (lane >> 3);
        ksrc[i] = R2 + (tok0 + kr) * R2_LD + h * 128 + (((lane & 15) ^ (kr & 15)) * 8);
        vsrc[i] = VT + ((size_t)((b * 4 + h) * 128 + vr)) * SEQ + (((lane & 7) ^ ((vr >> 1) & 7)) * 8); }
#define ATT_DMA(T_, stage) do { _Pragma("unroll") for (int u_ = 0; u_ < 2; ++u_) _Pragma("unroll") for (int i_ = 0; i_ < 2; ++i_) { \
        __builtin_amdgcn_global_load_lds((const unsigned*)(ksrc[i_] + (size_t)(2 * (T_) + u_) * 64 * R2_LD), (LAS unsigned*)(lds + (stage) * 65536 + u_ * ASTG + (wid + 8 * i_) * 1024), 16, 0, 0); \
        __builtin_amdgcn_global_load_lds((const unsigned*)(vsrc[i_] + (2 * (T_) + u_) * 64), (LAS unsigned*)(lds + (stage) * 65536 + u_ * ASTG + 16384 + (wid + 8 * i_) * 1024), 16, 0, 0); } } while (0)
    const int ND = qb + 1;
    if (wid >= 4) __builtin_amdgcn_s_setprio(1);
    ATT_DMA(0, 0);
    f32x4 o[2][8];
#pragma unroll
    for (int m = 0; m < 2; ++m)
#pragma unroll
        for (int nb = 0; nb < 8; ++nb) o[m][nb] = (f32x4){0.f, 0.f, 0.f, 0.f};
    float mrun[2] = {0.f, 0.f}, lrun[2] = {0.f, 0.f};
    int koff[2][2], voff[2];
#pragma unroll
    for (int m = 0; m < 2; ++m)
#pragma unroll
        for (int ks = 0; ks < 2; ++ks) koff[m][ks] = fr * 256 + (((m * 8 + ks * 4 + fq) ^ fr) * 16);
#pragma unroll
    for (int s2 = 0; s2 < 2; ++s2) voff[s2] = 16384 + fr * 128 + (((4 * s2 + fq) ^ ((fr >> 1) & 7)) * 16);
    asm volatile("s_waitcnt vmcnt(0)" ::: "memory"); __builtin_amdgcn_s_barrier(); asm volatile("" ::: "memory");
    for (int T = 0; T < ND; ++T) {
        const LAS unsigned char* sb = lds + (T & 1) * 65536;
        const bool skip2 = (T == ND - 1) && (wid < 4);
        bf16x8 pb[2][4];
#pragma unroll
        for (int m = 0; m < 2; ++m) {
            f32x4 s[2][4];
            const f32x4 negm = (f32x4){-mrun[m], -mrun[m], -mrun[m], -mrun[m]};
#define KFRAG(u_, j) (*(const LAS bf16x8*)(sb + (u_) * ASTG + ((j) >> 1) * 4096 + koff[m][(j) & 1]))
            __builtin_amdgcn_sched_barrier(0);
            { bf16x8 kf[4]; kf[0] = KFRAG(0, 0); kf[1] = KFRAG(0, 1); kf[2] = KFRAG(0, 2);
#pragma unroll
              for (int j = 0; j < 8; ++j) { const int kb = j >> 1, ks = j & 1;
                  if (j + 3 < 8) kf[(j + 3) & 3] = KFRAG(0, j + 3);
                  s[0][kb] = MFMA16(kf[j & 3], qf[m][ks], ks == 0 ? negm : s[0][kb]); }
              __builtin_amdgcn_sched_group_barrier(0x100, 3, 0);
#pragma unroll
              for (int j = 0; j < 5; ++j) { __builtin_amdgcn_sched_group_barrier(0x008, 1, 0); __builtin_amdgcn_sched_group_barrier(0x100, 1, 0); }
              __builtin_amdgcn_sched_group_barrier(0x008, 3, 0);
              __builtin_amdgcn_sched_barrier(0); }
            if (!skip2) {
                bf16x8 kf[4]; kf[0] = KFRAG(1, 0); kf[1] = KFRAG(1, 1); kf[2] = KFRAG(1, 2);
#pragma unroll
                for (int j = 0; j < 8; ++j) { const int kb = j >> 1, ks = j & 1;
                    if (j + 3 < 8) kf[(j + 3) & 3] = KFRAG(1, j + 3);
                    s[1][kb] = MFMA16(kf[j & 3], qf[m][ks], ks == 0 ? negm : s[1][kb]); }
                __builtin_amdgcn_sched_group_barrier(0x100, 3, 0);
#pragma unroll
                for (int j = 0; j < 5; ++j) { __builtin_amdgcn_sched_group_barrier(0x008, 1, 0); __builtin_amdgcn_sched_group_barrier(0x100, 1, 0); }
                __builtin_amdgcn_sched_group_barrier(0x008, 3, 0);
                __builtin_amdgcn_sched_barrier(0);
            } else {
#pragma unroll
                for (int kb = 0; kb < 4; ++kb) s[1][kb] = (f32x4){-1e30f, -1e30f, -1e30f, -1e30f};
            }
#undef KFRAG
            float mx = -1e30f;
#pragma unroll
            for (int u = 0; u < 2; ++u)
#pragma unroll
                for (int kb = 0; kb < 4; ++kb) { mx = __builtin_fmaxf(__builtin_fmaxf(mx, s[u][kb][0]), s[u][kb][1]); mx = __builtin_fmaxf(__builtin_fmaxf(mx, s[u][kb][2]), s[u][kb][3]); }
            mx = xmax16(mx); mx = xmax32(mx);
            if (T == 0 || __any(mx > 8.0f)) {
                const float dl = (T == 0) ? mx : fmaxf(mx, 0.f), f = __builtin_amdgcn_exp2f(-dl);
                mrun[m] += dl; lrun[m] *= f;
#pragma unroll
                for (int u = 0; u < 2; ++u)
#pragma unroll
                    for (int kb = 0; kb < 4; ++kb) s[u][kb] = s[u][kb] - dl;
#pragma unroll
                for (int nb = 0; nb < 8; ++nb) o[m][nb] = o[m][nb] * f;
            }
            float ps = 0.f;
#pragma unroll
            for (int u = 0; u < 2; ++u)
#pragma unroll
                for (int kb = 0; kb < 4; ++kb)
#pragma unroll
                    for (int j = 0; j < 4; ++j) { const float p = __builtin_amdgcn_exp2f(s[u][kb][j]); s[u][kb][j] = p; ps += p; }
            lrun[m] += ps;
#pragma unroll
            for (int u = 0; u < 2; ++u) { pb[m][2 * u] = pack8(s[u][0], s[u][1]); pb[m][2 * u + 1] = pack8(s[u][2], s[u][3]); }
        }
        if (T + 1 < ND) ATT_DMA(T + 1, (T + 1) & 1);
#pragma unroll
        for (int u = 0; u < 2; ++u) {
            if (u == 1 && skip2) continue;
            __builtin_amdgcn_sched_barrier(0);
            const LAS unsigned char* vb_ = sb + u * ASTG;
#define VFRAG(j) (*(const LAS bf16x8*)(vb_ + ((j) >> 1) * 2048 + voff[(j) & 1]))
            bf16x8 vf[4]; vf[0] = VFRAG(0); vf[1] = VFRAG(1); vf[2] = VFRAG(2);
#pragma unroll
            for (int j = 0; j < 16; ++j) { const int nb = j >> 1, s2 = j & 1;
                if (j + 3 < 16) vf[(j + 3) & 3] = VFRAG(j + 3);
                o[0][nb] = MFMA16(vf[j & 3], pb[0][2 * u + s2], o[0][nb]); o[1][nb] = MFMA16(vf[j & 3], pb[1][2 * u + s2], o[1][nb]);
            }
#undef VFRAG
            __builtin_amdgcn_sched_group_barrier(0x100, 3, 0);
#pragma unroll
            for (int j = 0; j < 13; ++j) { __builtin_amdgcn_sched_group_barrier(0x008, 2, 0); __builtin_amdgcn_sched_group_barrier(0x100, 1, 0); }
            __builtin_amdgcn_sched_group_barrier(0x008, 6, 0);
            __builtin_amdgcn_sched_barrier(0);
        }
        asm volatile("s_waitcnt vmcnt(0)" ::: "memory");
        __builtin_amdgcn_s_barrier(); asm volatile("" ::: "memory");
    }
#undef ATT_DMA
    __builtin_amdgcn_s_setprio(0);
    float l0 = lrun[0], l1 = lrun[1];
    l0 += __shfl_xor(l0, 16); l0 += __shfl_xor(l0, 32); l1 += __shfl_xor(l1, 16); l1 += __shfl_xor(l1, 32);
    const float i0 = 1.0f / l0, i1 = lam / l1;
    float ss = 0.f;
#pragma unroll
    for (int nb = 0; nb < 8; ++nb) { o[0][nb] = o[0][nb] * i0 - o[1][nb] * i1; ss += (o[0][nb][0] * o[0][nb][0] + o[0][nb][1] * o[0][nb][1]) + (o[0][nb][2] * o[0][nb][2] + o[0][nb][3] * o[0][nb][3]); }
    ss += __shfl_xor(ss, 16); ss += __shfl_xor(ss, 32);
    const float rr = one_m_lam_init / sqrtf(ss * (1.f / 128.f) + EPS);
    const int cst = 16 * (fq & 1) + 8 * (fq >> 1);
    const bf16_t* gap = R2 + (tok0 + qrow) * R2_LD + 512 + h * 128 + cst;
    bf16_t* yp = R1 + (tok0 + qrow) * R1_LD + h * 128 + cst;
#pragma unroll
    for (int p = 0; p < 4; ++p) { const u32x4 g4 = *(const u32x4*)(gap + p * 32);
        const f32x4 sa = *(const f32x4*)(subln_g + (2 * p) * 16 + fq * 4), sb = *(const f32x4*)(subln_g + (2 * p + 1) * 16 + fq * 4);
        f32x4 a = o[0][2 * p] * rr * sa, b = o[0][2 * p + 1] * rr * sb;
        swap16x4(a, b);
        u32x4 w; w.x = pg8::cvt_pk_bf16(a[0] * pg8::bflo(g4.x), a[1] * pg8::bfhi(g4.x)); w.y = pg8::cvt_pk_bf16(a[2] * pg8::bflo(g4.y), a[3] * pg8::bfhi(g4.y));
        w.z = pg8::cvt_pk_bf16(b[0] * pg8::bflo(g4.z), b[1] * pg8::bfhi(g4.z)); w.w = pg8::cvt_pk_bf16(b[2] * pg8::bflo(g4.w), b[3] * pg8::bfhi(g4.w));
        if (do_store) *(u32x4*)(yp + p * 32) = w; }
}

constexpr int MSTR = 272, MBUF = 128 * MSTR;
__device__ __forceinline__ void mix_gemm(const LAS unsigned char* la, const LAS unsigned char* lb, f32x4 (&acc)[4][2], int wr, int wc, int fr, int fq) {
#pragma unroll
    for (int mi = 0; mi < 4; ++mi)
#pragma unroll
        for (int ni = 0; ni < 2; ++ni) acc[mi][ni] = (f32x4){0.f, 0.f, 0.f, 0.f};
#pragma unroll
    for (int ks = 0; ks < 4; ++ks) {
        bf16x8 bfr[2], afr[4];
#pragma unroll
        for (int ni = 0; ni < 2; ++ni) bfr[ni] = *(const LAS bf16x8*)(lb + (wc * 32 + ni * 16 + fr) * MSTR + ks * 64 + fq * 16);
#pragma unroll
        for (int mi = 0; mi < 4; ++mi) afr[mi] = *(const LAS bf16x8*)(la + (wr * 64 + mi * 16 + fr) * MSTR + ks * 64 + fq * 16);
#pragma unroll
        for (int mi = 0; mi < 4; ++mi)
#pragma unroll
            for (int ni = 0; ni < 2; ++ni) acc[mi][ni] = MFMA16(bfr[ni], afr[mi], acc[mi][ni]);
    }
}

__device__ __forceinline__ void pool_unit(int tb, int g, bf16_t* R1, const bf16_t* R2, const bf16_t* PWl, const float* pool_b, const float* pool_scale, LAS unsigned char* lds, bool do_store) {
    const int tid = opaque_tid(), lane = tid & 63, wid = __builtin_amdgcn_readfirstlane(tid >> 6), fr = lane & 15, fq = lane >> 4, wr = wid >> 2, wc = wid & 3;
    LAS unsigned char* la = lds; LAS unsigned char* lb = lds + MBUF; LAS unsigned char* lp = lds + 2 * MBUF;
    const int W = 2 << g; const int t0 = tb * 128; const bool first = (t0 & (SEQ - 1)) == 0;
    const int cst = wc * 32 + 16 * (fq & 1) + 8 * (fq >> 1);
    u32x4 ggv[4]; f32x4 pbv[2], scv[2];
#pragma unroll
    for (int ni = 0; ni < 2; ++ni) { const int col = g * 128 + wc * 32 + ni * 16 + fq * 4; pbv[ni] = *(const f32x4*)(pool_b + col); scv[ni] = *(const f32x4*)(pool_scale + col); }
#pragma unroll
    for (int mi = 0; mi < 4; ++mi) ggv[mi] = *(const u32x4*)(R1 + (size_t)(tb * 128 + wr * 64 + mi * 16 + fr) * R1_LD + 512 + g * 128 + cst);
#pragma unroll
    for (int i = 0; i < 4; ++i) { const int p = tid + 512 * i, row = p >> 4, ch = p & 15;
        *(LAS u32x4*)(lb + row * MSTR + ch * 16) = *(const u32x4*)(PWl + (size_t)g * 128 * 128 + row * 128 + ch * 8); }
#pragma unroll
    for (int i = 0; i < 5; ++i) { const int p = tid + 512 * i, row = p >> 4, ch = p & 15;
        if (row < 143) { u32x4 v = (u32x4){0u, 0u, 0u, 0u}; if (!(first && row < 15)) v = *(const u32x4*)(R2 + (size_t)(t0 - 15 + row) * R2_LD + 1024 + g * 128 + ch * 8);
            *(LAS u32x4*)(lp + row * MSTR + ch * 16) = v; } }
    __syncthreads();
    { const int tg = tid >> 4, ch = tid & 15, T0 = 4 * tg; const int s0 = (t0 + T0) & (SEQ - 1);
      const LAS unsigned char* src = lp + (T0 + 15) * MSTR + ch * 16;
      float a[8];
#pragma unroll
      for (int e = 0; e < 8; ++e) a[e] = 0.f;
      u32x4 w = (u32x4){0u, 0u, 0u, 0u};
      for (int k = W - 1; k >= 0; --k) { w = *(const LAS u32x4*)(src - k * MSTR);
          a[0] += pg8::bflo(w.x); a[1] += pg8::bfhi(w.x); a[2] += pg8::bflo(w.y); a[3] += pg8::bfhi(w.y); a[4] += pg8::bflo(w.z); a[5] += pg8::bfhi(w.z); a[6] += pg8::bflo(w.w); a[7] += pg8::bfhi(w.w); }
#pragma unroll
      for (int d = 0; d < 4; ++d) {
          if (d > 0) { w = *(const LAS u32x4*)(src + d * MSTR); const u32x4 wo = *(const LAS u32x4*)(src + (d - W) * MSTR);
              a[0] += pg8::bflo(w.x) - pg8::bflo(wo.x); a[1] += pg8::bfhi(w.x) - pg8::bfhi(wo.x); a[2] += pg8::bflo(w.y) - pg8::bflo(wo.y); a[3] += pg8::bfhi(w.y) - pg8::bfhi(wo.y);
              a[4] += pg8::bflo(w.z) - pg8::bflo(wo.z); a[5] += pg8::bfhi(w.z) - pg8::bfhi(wo.z); a[6] += pg8::bflo(w.w) - pg8::bflo(wo.w); a[7] += pg8::bfhi(w.w) - pg8::bfhi(wo.w); }
          const int sd = s0 + d; const int cnt = (sd + 1 < W) ? (sd + 1) : W; const float ic = 1.0f / (float)cnt;
          u32x4 ov; ov.x = pg8::cvt_pk_bf16(a[0] * ic - pg8::bflo(w.x), a[1] * ic - pg8::bfhi(w.x)); ov.y = pg8::cvt_pk_bf16(a[2] * ic - pg8::bflo(w.y), a[3] * ic - pg8::bfhi(w.y));
          ov.z = pg8::cvt_pk_bf16(a[4] * ic - pg8::bflo(w.z), a[5] * ic - pg8::bfhi(w.z)); ov.w = pg8::cvt_pk_bf16(a[6] * ic - pg8::bflo(w.w), a[7] * ic - pg8::bfhi(w.w));
          *(LAS u32x4*)(la + (T0 + d) * MSTR + ch * 16) = ov; } }
    __syncthreads();
    f32x4 acc[4][2];
    mix_gemm(la, lb, acc, wr, wc, fr, fq);
#pragma unroll
    for (int mi = 0; mi < 4; ++mi) { const int t = tb * 128 + wr * 64 + mi * 16 + fr;
        f32x4 a = (acc[mi][0] + pbv[0]) * scv[0], b = (acc[mi][1] + pbv[1]) * scv[1];
        swap16x4(a, b);
        const u32x4 g4 = ggv[mi];
        u32x4 w; w.x = pg8::cvt_pk_bf16(a[0] * pg8::bflo(g4.x), a[1] * pg8::bfhi(g4.x)); w.y = pg8::cvt_pk_bf16(a[2] * pg8::bflo(g4.y), a[3] * pg8::bfhi(g4.y));
        w.z = pg8::cvt_pk_bf16(b[0] * pg8::bflo(g4.z), b[1] * pg8::bfhi(g4.z)); w.w = pg8::cvt_pk_bf16(b[2] * pg8::bflo(g4.w), b[3] * pg8::bfhi(g4.w));
        if (do_store) *(u32x4*)(R1 + (size_t)t * R1_LD + 512 + g * 128 + cst) = w; }
    __syncthreads();
}

__device__ __forceinline__ void sgu_unit(int tb, int g, bf16_t* R1, const bf16_t* R2, const bf16_t* SWl, const float* ln_g, const float* ln_b, const float* sgu_b, const f32x2* SVST, LAS unsigned char* lds, bool do_store) {
    const int tid = opaque_tid(), lane = tid & 63, wid = __builtin_amdgcn_readfirstlane(tid >> 6), fr = lane & 15, fq = lane >> 4, wr = wid >> 2, wc = wid & 3;
    LAS unsigned char* la = lds; LAS unsigned char* lb = lds + MBUF;
    const int cst = wc * 32 + 16 * (fq & 1) + 8 * (fq >> 1);
    u32x4 ggv[4], uuv[4]; float bsv[4];
#pragma unroll
    for (int mi = 0; mi < 4; ++mi) { const int ipos = wr * 64 + mi * 16 + fr; bsv[mi] = sgu_b[g * 128 + ipos]; const size_t t = (size_t)(tb * 128 + ipos);
        ggv[mi] = *(const u32x4*)(R1 + t * R1_LD + 1024 + g * 128 + cst); uuv[mi] = *(const u32x4*)(R2 + t * R2_LD + 1536 + g * 128 + cst); }
    LAS f32x2* st = (LAS f32x2*)(lds + 2 * MBUF);
    if (tid < 128) { const f32x4* sp = (const f32x4*)(SVST + (size_t)(tb * 128 + tid) * 8); const f32x4 a0 = sp[0], a1 = sp[1], a2 = sp[2], a3 = sp[3];
        const float m0 = ((a0.x + a0.z) + (a1.x + a1.z) + (a2.x + a2.z) + (a3.x + a3.z)) * (1.f / 512.f), q0 = ((a0.y + a0.w) + (a1.y + a1.w) + (a2.y + a2.w) + (a3.y + a3.w)) * (1.f / 512.f);
        st[tid] = (f32x2){m0, 1.0f / sqrtf(fmaxf(q0 - m0 * m0, 0.f) + EPS)}; }
#pragma unroll
    for (int i = 0; i < 4; ++i) { const int p = tid + 512 * i, row = p >> 4, ch = p & 15;
        *(LAS u32x4*)(la + row * MSTR + ch * 16) = *(const u32x4*)(SWl + (size_t)g * 128 * 128 + row * 128 + ch * 8); }
    u32x4 rw[2][2];
#pragma unroll
    for (int i = 0; i < 2; ++i) { const int ci = i * 8 + wid, tp = (ci & 3) * 16 + (lane & 15), ch = (ci >> 2) * 4 + (lane >> 4);
        const bf16_t* src = R2 + (size_t)(tb * 128 + 2 * tp) * R2_LD + 2048 + g * 128 + ch * 8;
        rw[i][0] = *(const u32x4*)src; rw[i][1] = *(const u32x4*)(src + R2_LD); }
    __syncthreads();
#pragma unroll
    for (int i = 0; i < 2; ++i) { const int ci = i * 8 + wid, tp = (ci & 3) * 16 + (lane & 15), ch = (ci >> 2) * 4 + (lane >> 4);
        const u32x4 w0 = rw[i][0], w1 = rw[i][1];
        const f32x2 ms0 = st[2 * tp], ms1 = st[2 * tp + 1];
        const f32x4 g0 = *(const f32x4*)(ln_g + g * 128 + ch * 8), g1 = *(const f32x4*)(ln_g + g * 128 + ch * 8 + 4), b0 = *(const f32x4*)(ln_b + g * 128 + ch * 8), b1 = *(const f32x4*)(ln_b + g * 128 + ch * 8 + 4);
        const float va[8] = {pg8::bflo(w0.x), pg8::bfhi(w0.x), pg8::bflo(w0.y), pg8::bfhi(w0.y), pg8::bflo(w0.z), pg8::bfhi(w0.z), pg8::bflo(w0.w), pg8::bfhi(w0.w)};
        const float vb[8] = {pg8::bflo(w1.x), pg8::bfhi(w1.x), pg8::bflo(w1.y), pg8::bfhi(w1.y), pg8::bflo(w1.z), pg8::bfhi(w1.z), pg8::bflo(w1.w), pg8::bfhi(w1.w)};
#pragma unroll
        for (int e = 0; e < 8; ++e) { const float gg = e < 4 ? g0[e & 3] : g1[e & 3], bb = e < 4 ? b0[e & 3] : b1[e & 3];
            *(LAS unsigned*)(lb + (ch * 8 + e) * MSTR + tp * 4) = pg8::cvt_pk_bf16((va[e] - ms0.x) * ms0.y * gg + bb, (vb[e] - ms1.x) * ms1.y * gg + bb); } }
    __syncthreads();
    f32x4 acc[4][2];
    mix_gemm(la, lb, acc, wr, wc, fr, fq);
#pragma unroll
    for (int mi = 0; mi < 4; ++mi) { const int ipos = wr * 64 + mi * 16 + fr, t = tb * 128 + ipos; const float bs = bsv[mi];
        f32x4 a = acc[mi][0] + bs, b = acc[mi][1] + bs;
        swap16x4(a, b);
        const u32x4 g4 = ggv[mi], u4 = uuv[mi];
        u32x4 w; w.x = pg8::cvt_pk_bf16(a[0] * pg8::bflo(u4.x) * pg8::bflo(g4.x), a[1] * pg8::bfhi(u4.x) * pg8::bfhi(g4.x)); w.y = pg8::cvt_pk_bf16(a[2] * pg8::bflo(u4.y) * pg8::bflo(g4.y), a[3] * pg8::bfhi(u4.y) * pg8::bfhi(g4.y));
        w.z = pg8::cvt_pk_bf16(b[0] * pg8::bflo(u4.z) * pg8::bflo(g4.z), b[1] * pg8::bfhi(u4.z) * pg8::bfhi(g4.z)); w.w = pg8::cvt_pk_bf16(b[2] * pg8::bflo(u4.w) * pg8::bflo(g4.w), b[3] * pg8::bfhi(u4.w) * pg8::bfhi(g4.w));
        if (do_store) *(u32x4*)(R1 + (size_t)t * R1_LD + 1024 + g * 128 + cst) = w; }
    __syncthreads();
}

#define RLX_AGENT __ATOMIC_RELAXED, __HIP_MEMORY_SCOPE_AGENT
#define XB_TMO      128
#define XB_XCNT(j)  (256  + 64 * (j))
#define XB_XSUB(j)  (1280 + 64 * (j))
#define XB_XGEN(j)  (2304 + 64 * (j))
#define XB_TOP      3328
#define XB_TOPGEN   3392
#define XCD_BAR_WORDS 3456
#define XB_SPIN_CAP (1u << 18)

__device__ __forceinline__ unsigned xb_ld(unsigned* p)              { return __hip_atomic_load(p, __ATOMIC_RELAXED, __HIP_MEMORY_SCOPE_AGENT); }
__device__ __forceinline__ unsigned xb_add(unsigned* p, unsigned v) { return __hip_atomic_fetch_add(p, v, __ATOMIC_RELAXED, __HIP_MEMORY_SCOPE_AGENT); }
__device__ __forceinline__ unsigned xb_xcc_id() { return (unsigned)__builtin_amdgcn_s_getreg((3 << 11) | 20) & 0xFu; }
#define XB_SPIN(cond, bar) do { unsigned _sp = 0; while (cond) { __builtin_amdgcn_s_sleep(1); \
    if ((++_sp & 255u) == 0u) { if (xb_ld(&(bar)[XB_TMO])) break; if (_sp > XB_SPIN_CAP) { atomicAdd(&(bar)[XB_TMO], 1u); break; } } } } while (0)

struct XcdBarrier {
    unsigned* bar; unsigned x;
    volatile LAS unsigned* st;
};

__device__ __forceinline__ XcdBarrier xcd_barrier_post(unsigned* bar, volatile LAS unsigned* st) {
    XcdBarrier b; b.bar = bar; b.x = xb_xcc_id(); b.st = st;
    if (threadIdx.x == 0) (void)xb_add(&bar[XB_XCNT(b.x)], 1u);
    return b;
}
__device__ __forceinline__ void xcd_barrier_complete(unsigned* bar, unsigned x, unsigned& nloc, unsigned& nx) {
    const unsigned G = gridDim.x * gridDim.y * gridDim.z;
    unsigned sum, cnt, mine, sp = 0u;
    for (;;) {
        sum = 0u; cnt = 0u; mine = 0u;
#pragma unroll
        for (unsigned j = 0; j < 16; ++j) { const unsigned c = xb_ld(&bar[XB_XCNT(j)]); sum += c; cnt += (c > 0u) ? 1u : 0u; mine = (j == x) ? c : mine; }
        if (sum == G) break;
        __builtin_amdgcn_s_sleep(1);
        if ((++sp & 255u) == 0u) { if (xb_ld(&bar[XB_TMO])) break; if (sp > XB_SPIN_CAP) { atomicAdd(&bar[XB_TMO], 1u); break; } }
    }
    nloc = mine > 0u ? mine : 1u; nx = cnt > 0u ? cnt : 1u;
}

__device__ __forceinline__ void xcd_barrier(const XcdBarrier& b) {
    asm volatile("s_waitcnt vmcnt(0)" ::: "memory");
    __syncthreads();
    if (threadIdx.x == 0) {
        unsigned* bar = b.bar;
        __builtin_amdgcn_s_waitcnt(0);
        unsigned nloc = b.st[0], nx = b.st[1];
        if (nloc == 0u) { xcd_barrier_complete(bar, b.x, nloc, nx); b.st[0] = nloc; b.st[1] = nx; }
        const unsigned old = xb_add(&bar[XB_XSUB(b.x)], 1u);
        const unsigned gen = old / nloc;
        if (old + 1u == (gen + 1u) * nloc) {
            __builtin_amdgcn_fence(__ATOMIC_RELEASE, "agent");
            asm volatile("s_waitcnt vmcnt(0)" ::: "memory");
            const unsigned og = xb_add(&bar[XB_TOP], 1u);
            const unsigned tg = og / nx;
            if (og + 1u == (tg + 1u) * nx) xb_add(&bar[XB_TOPGEN], 1u);
            else XB_SPIN(xb_ld(&bar[XB_TOPGEN]) == tg, bar);
            __builtin_amdgcn_fence(__ATOMIC_ACQUIRE, "agent");
            asm volatile("s_waitcnt vmcnt(0)" ::: "memory");
        } else {
            XB_SPIN(xb_ld(&bar[XB_TOPGEN]) == gen, bar);
            __builtin_amdgcn_fence(__ATOMIC_ACQUIRE, "agent");
            asm volatile("s_waitcnt vmcnt(0)" ::: "memory");
        }
    }
    __syncthreads();
}

constexpr int N_PHASES = 1 + 6 * DEPTH;
typedef const __attribute__((address_space(4))) Args* KArgs;
#define FRESH_ARGS() KArgs ap = (KArgs)__builtin_amdgcn_kernarg_segment_ptr(); asm volatile("" : "+s"(ap)); unsigned char* ws = ap->ws
__global__ void __launch_bounds__(NTHREADS, 2) hybrid_fwd(Args a_unused) {
    extern __shared__ __attribute__((aligned(16))) unsigned char lds_raw[];
    LAS unsigned char* lds = (LAS unsigned char*)lds_raw;
    cg::grid_group grid = cg::this_grid();
    int lo, hi; { FRESH_ARGS(); (void)ws; lo = ap->ph_lo; hi = ap->ph_hi; }
    if (threadIdx.x < 2) ((volatile LAS unsigned*)(lds + LDS_BYTES - 64))[threadIdx.x] = 0u;
    __syncthreads();
    if (lo < 0) grid.sync();
    XcdBarrier xbar; { FRESH_ARGS(); xbar = xcd_barrier_post((unsigned*)(ws + WS_CTL), (volatile LAS unsigned*)(lds + LDS_BYTES - 64)); }
#define GV() const int G = gridDim.x, bx = blockIdx.x; const int vcu = (G % 8 == 0) ? (bx % 8) * (G / 8) + bx / 8 : bx; (void)vcu; (void)bx
#define IN(k) (lo <= (k) && (k) < hi)
#ifdef SEAM2
#define SEAM(k) do { if (IN(k) && IN((k) + 1)) { xcd_barrier(xbar); xcd_barrier(xbar); } } while (0)
#else
#define SEAM(k) do { if (IN(k) && IN((k) + 1)) xcd_barrier(xbar); } while (0)
#endif

#ifndef SKIP_P0
    if (IN(0)) { FRESH_ARGS(); GV(); P0Args a{ap->x, ap->pre_g, ap->w_in, ap->w_merge, ap->w_branch, ap->w_out, ap->pool_w, ap->sgu_w, ws}; p0_prologue(a, lds, vcu, G); __syncthreads();
#ifdef REP_P0
        p0_prologue(a, lds, vcu, G); __syncthreads();
#endif
    }
#endif
    SEAM(0);
#pragma unroll 1
    for (int l = 0; l < DEPTH; ++l) {
        const int pb = 1 + 6 * l;
#ifndef SKIP_P1
        if (IN(pb)) { FRESH_ARGS(); GV();
            pg8::Gemm g{(bf16_t*)(ws + WS_H), (bf16_t*)(ws + WS_WCAT) + l * WCAT_L, 1024, 1024, 1024, 0}; pg8::StaticOrderH S; S.init(M, INW, G, bx);
            pg8::EpiZ E{(bf16_t*)(ws + WS_R1), (bf16_t*)(ws + WS_R2), (bf16_t*)(ws + WS_VT), (f32x2*)(ws + WS_SVST)};
#ifdef REP_P1
            pg8::gemm_phase<pg8::EpiZ, pg8::StaticOrderH, true, true>(lds, g, S, E);
#endif
            pg8::gemm_phase<pg8::EpiZ, pg8::StaticOrderH, true, true>(lds, g, S, E);
        }
#endif
        SEAM(pb);
#ifndef SKIP_P2
        if (IN(pb + 1)) { FRESH_ARGS(); GV();
            const int lane = opaque_tid() & 63;
            bf16_t* R1 = (bf16_t*)(ws + WS_R1); const bf16_t* R2 = (const bf16_t*)(ws + WS_R2); const bf16_t* VT = (const bf16_t*)(ws + WS_VT);
            float lam, omli;
            { const float a1 = wave_sum(ap->lq1[l * 64 + lane] * ap->lk1[l * 64 + lane]), a2 = wave_sum(ap->lq2[l * 64 + lane] * ap->lk2[l * 64 + lane]);
              const float li = 0.8f - 0.6f * __expf(-0.3f * (float)l); lam = __expf(a1) - __expf(a2) + li; omli = 1.0f - li; }
            const float* subln = ap->subln_g + l * 128;
#ifdef REP_ATT
            for (int rep = 0; rep < 2; ++rep) { const bool st = (rep == 1) ? (lo >= 0) : (lo < 0);
#else
            { const bool st = true;
#endif
            for (int pr = vcu; pr < 256; pr += G) { const int bh = pr >> 3, i = pr & 7;
                attn_unit(bh >> 2, bh & 3, 15 - i, R1, R2, VT, subln, lam, omli, lds, st);
                attn_unit(bh >> 2, bh & 3, i, R1, R2, VT, subln, lam, omli, lds, st); } }
            const bf16_t* PWl = (const bf16_t*)(ws + WS_PW) + (size_t)l * 4 * 128 * 128; const bf16_t* SWl = (const bf16_t*)(ws + WS_SW) + (size_t)l * 4 * 128 * 128;
#ifdef REP_MIX
            for (int rep = 0; rep < 2; ++rep) { const bool st = (rep == 1) ? (lo >= 0) : (lo < 0);
#else
            { const bool st = true;
#endif
            for (int u = vcu; u < 1024; u += G) { const int w_ = u & 511, rnd = w_ >> 8, vv = w_ & 255; const int tb = rnd * 64 + (vv >> 2), g = rnd ? 3 - (vv & 3) : (vv & 3);
                if (u < 512) pool_unit(tb, g, R1, R2, PWl, ap->pool_b + l * 512, ap->pool_scale + l * 512, lds, st);
                else sgu_unit(tb, g, R1, R2, SWl, ap->sgu_ln_g + l * 512, ap->sgu_ln_b + l * 512, ap->sgu_b + l * 512, (const f32x2*)(ws + WS_SVST), lds, st); } }
        }
#endif
        SEAM(pb + 1);
#ifndef SKIP_P25
        if (IN(pb + 2)) { FRESH_ARGS(); GV();
            pg8::Gemm g{(bf16_t*)(ws + WS_H), (bf16_t*)(ws + WS_WCAT) + l * WCAT_L + (size_t)INW * 1024, 1024, 1024, 1024, 0}; pg8::StaticOrder S; S.init(M, GATEW, G, bx);
            pg8::EpiGate E{(bf16_t*)(ws + WS_GATE), ap->b_merge + l * GATEW};
#ifdef REP_P25
            pg8::gemm_phase<pg8::EpiGate, pg8::StaticOrder, true, true>(lds, g, S, E);
#endif
            pg8::gemm_phase<pg8::EpiGate, pg8::StaticOrder, true, true>(lds, g, S, E);
        }
#endif
        SEAM(pb + 2);
#ifndef SKIP_P3
        if (IN(pb + 3)) { FRESH_ARGS(); GV();
            pg8::Gemm g{(bf16_t*)(ws + WS_R1), (bf16_t*)(ws + WS_WB) + l * WB_L, 1536, 1536, 512, 1024}; pg8::StaticOrder3 S; S.init(M, D, G, bx);
            pg8::EpiMerge E{(bf16_t*)(ws + WS_GATE), (bf16_t*)(ws + WS_H)};
#ifdef REP_P3
            pg8::gemm_phase<pg8::EpiMerge, pg8::StaticOrder3, true, true>(lds, g, S, E);
#endif
            pg8::gemm_phase<pg8::EpiMerge, pg8::StaticOrder3, true, true>(lds, g, S, E);
        }
#endif
        SEAM(pb + 3);
#ifndef SKIP_P4
        if (IN(pb + 4)) { FRESH_ARGS(); GV();
            pg8::Gemm g{(bf16_t*)(ws + WS_H), (bf16_t*)(ws + WS_WO) + l * WO_L, 1024, 1024, 1024, 0}; pg8::StaticOrder S; S.init(M, D, G, bx);
            pg8::EpiOut E{(bf16_t*)(ws + WS_OUT), (float*)(ws + WS_SSQ)};
#ifdef REP_P4
            pg8::gemm_phase<pg8::EpiOut, pg8::StaticOrder, true, true>(lds, g, S, E);
#endif
            pg8::gemm_phase<pg8::EpiOut, pg8::StaticOrder, true, true>(lds, g, S, E);
        }
#endif
        SEAM(pb + 4);
#ifndef SKIP_P5
        if (IN(pb + 5)) { FRESH_ARGS(); GV();
#ifdef REP_P5L0
            if (l == 0) p5_rows<false, true>(ap->x, (const bf16_t*)(ws + WS_OUT), (const float*)(ws + WS_SSQ), ap->post_g + l * D, ap->pre_g + (l + 1) * D, ws + WS_X1, (bf16_t*)(ws + WS_H), vcu, G);
#endif
            if (l + 1 < DEPTH) p5_rows<false, true>(ap->x, (const bf16_t*)(ws + WS_OUT), (const float*)(ws + WS_SSQ), ap->post_g + l * D, ap->pre_g + (l + 1) * D, ws + WS_X1, (bf16_t*)(ws + WS_H), vcu, G);
            else p5_rows<true, false>(ws + WS_X1, (const bf16_t*)(ws + WS_OUT), (const float*)(ws + WS_SSQ), ap->post_g + l * D, nullptr, ap->out, (bf16_t*)(ws + WS_H), vcu, G);
        }
#endif
        SEAM(pb + 5);
    }
#undef IN
#undef SEAM
}

#ifndef MK_N_LAUNCHES
#define MK_N_LAUNCHES 1
#endif
extern "C" void kernel_launch(void* const* d_in, const int* in_sizes, int n_in, void* d_out, int out_size, void* d_ws, size_t ws_size, hipStream_t stream) {
    static int grid = 0;
    if (grid == 0) {
        if (n_in != 20 || in_sizes[0] != M * D || out_size != M * D || ws_size < WS_END) { fprintf(stderr, "kernel_launch: unexpected shapes (n_in %d in0 %d out %d ws %zu)\n", n_in, n_in > 0 ? in_sizes[0] : -1, out_size, ws_size); grid = -1; return; }
        int dev = 0, cus = 0, per_cu = 0;
        hipGetDevice(&dev); hipDeviceGetAttribute(&cus, hipDeviceAttributeMultiprocessorCount, dev);
        if (hipFuncSetAttribute((const void*)hybrid_fwd, hipFuncAttributeMaxDynamicSharedMemorySize, LDS_BYTES) != hipSuccess) { fprintf(stderr, "kernel_launch: hipFuncSetAttribute failed\n"); grid = -1; return; }
        if (hipOccupancyMaxActiveBlocksPerMultiprocessor(&per_cu, (const void*)hybrid_fwd, NTHREADS, LDS_BYTES) != hipSuccess || per_cu < 1) { fprintf(stderr, "kernel_launch: occupancy query says %d\n", per_cu); per_cu = 1; }
        (void)hipGetLastError();
        grid = cus * (per_cu > 1 ? 1 : per_cu);
        fprintf(stderr, "kernel_launch: grid %d (cus %d, per_cu %d)\n", grid, cus, per_cu);
    }
    if (grid < 0) return;
    Args a{};
    const float* const* in = (const float* const*)d_in;
    a.x = in[0]; a.pre_g = in[1]; a.post_g = in[2]; a.w_in = in[3]; a.lq1 = in[4]; a.lk1 = in[5]; a.lq2 = in[6]; a.lk2 = in[7];
    a.subln_g = in[8]; a.pool_w = in[9]; a.pool_b = in[10]; a.pool_scale = in[11]; a.sgu_ln_g = in[12]; a.sgu_ln_b = in[13]; a.sgu_w = in[14]; a.sgu_b = in[15];
    a.w_branch = in[16]; a.w_merge = in[17]; a.b_merge = in[18]; a.w_out = in[19];
    a.out = (float*)d_out; a.ws = (unsigned char*)d_ws;
    if (hipMemsetAsync((unsigned char*)d_ws + WS_CTL, 0, XCD_BAR_WORDS * 4, stream) != hipSuccess) { fprintf(stderr, "kernel_launch: memset failed\n"); return; }
#if MK_N_LAUNCHES == 1
    a.ph_lo = 0; a.ph_hi = N_PHASES;
    void* args[] = {&a};
    hipError_t e = hipLaunchCooperativeKernel((const void*)hybrid_fwd, dim3(grid), dim3(NTHREADS), args, LDS_BYTES, stream);
    if (e != hipSuccess) fprintf(stderr, "cooperative launch failed: %s (grid %d)\n", hipGetErrorString(e), grid);
#else
    for (int p = 0; p < N_PHASES; ++p) { a.ph_lo = p; a.ph_hi = p + 1; hipLaunchKernelGGL(hybrid_fwd, dim3(grid), dim3(NTHREADS), LDS_BYTES, stream, a); }
#endif
}
```

```cpp
#include <hip/hip_runtime.h>
#include <hip/hip_cooperative_groups.h>
#include <cstdio>
#include <cstdint>
namespace cg = cooperative_groups;

__device__ __forceinline__ int opaque_tid() { int t = threadIdx.x; asm volatile("" : "+v"(t)); return t; }
namespace pg8 {
#define PG8_LAS __attribute__((address_space(3)))
typedef unsigned short bf16_t;
typedef short bf16x8 __attribute__((ext_vector_type(8)));
typedef short s16x4 __attribute__((ext_vector_type(4)));
typedef float f32x4 __attribute__((ext_vector_type(4)));
typedef float f32x2 __attribute__((ext_vector_type(2)));
typedef unsigned u32x4 __attribute__((ext_vector_type(4)));
typedef unsigned u32x2 __attribute__((ext_vector_type(2)));
constexpr int BM = 256, BK = 64, HALF = 128, HTB = HALF * BK * 2  , STAGE_BYTES = 8 * HTB, NXCD = 8, WGM = 4;

__host__ __device__ __forceinline__ int lds_byte(int r, int c) { const int st = (r >> 4) * 2 + (c >> 5), rr = r & 15, cc = c & 31, ob = rr * 64 + cc * 2; return st * 1024 + (ob ^ (((ob >> 9) & 1) << 5)); }
__host__ __device__ __forceinline__ void stage_rc(int b, int& R, int& C) { const int st = b / 1024, sb = b % 1024, swz = sb ^ (((sb >> 9) & 1) << 5); R = (st >> 1) * 16 + swz / 64; C = (st & 1) * 32 + (swz % 64) / 2; }
__host__ __device__ __forceinline__ int perm32(int rho) { const int n = rho >> 4, i = rho & 15; return 8 * (i >> 2) + 4 * n + (i & 3); }

struct Unit { int pm, pn, kz, half; };
struct Gemm { const bf16_t* A; const bf16_t* Bt; int lda, ldb, K, kzstep; };

struct StaticOrder {
    int nM, nN, nwg, G, c;
    __host__ __device__ void init(int M, int N, int G_, int c_) { nM = M / BM; nN = N / BM; nwg = nM * nN; G = G_; c = c_; }
    __host__ __device__ bool next(int i, Unit& u) const {
        const long L = (long)i * G + c; if (L >= nwg) return false;
        int wgid = (int)L; { const int q = nwg / NXCD, r = nwg % NXCD, xcd = wgid % NXCD, off = wgid / NXCD; wgid = (xcd < r ? xcd * (q + 1) : r * (q + 1) + (xcd - r) * q) + off; }
        const int nig = WGM * nN, gid = wgid / nig, fm = gid * WGM, gsz = (nM - fm) < WGM ? (nM - fm) : WGM;
        u.pm = fm + ((wgid % nig) % gsz); u.pn = (wgid % nig) / gsz; u.kz = 0; u.half = 0; return true;
    }
    __device__ __forceinline__ void a_ready(const Unit&) const {}
    __device__ __forceinline__ void done(const Unit&) const {}
};
struct StaticOrderH {
    StaticOrder so;
    __host__ __device__ void init(int M, int N, int G_, int c_) { so.init(M, N, G_, c_); }
    __host__ __device__ bool next(int i, Unit& u) const {
        const int full = so.nwg / so.G, rem = so.nwg - full * so.G;
        if (i == full && rem * 2 == so.G) { StaticOrder t = so; t.c = so.c >> 1; if (!t.next(i, u)) return false; u.half = 1 + (so.c & 1); return true; }
        return so.next(i, u);
    }
    __device__ __forceinline__ void a_ready(const Unit&) const {}
    __device__ __forceinline__ void done(const Unit&) const {}
};
struct StaticOrder3 {
    StaticOrder so;
    __host__ __device__ void init(int M, int N, int G_, int c_) { so.init(M, N, G_, c_); }
    __host__ __device__ bool next(int i, Unit& u) const { if (!so.next(i / 3, u)) return false; u.kz = i % 3; return true; }
    __device__ __forceinline__ void a_ready(const Unit&) const {}
    __device__ __forceinline__ void done(const Unit&) const {}
};

__device__ __forceinline__ unsigned cvt_pk_bf16(float lo, float hi) { unsigned r; asm volatile("v_cvt_pk_bf16_f32 %0, %1, %2" : "=v"(r) : "v"(lo), "v"(hi)); return r; }
__device__ __forceinline__ f32x2 gelu_pk(f32x2 v) {
    const f32x2 av = __builtin_elementwise_abs(v), d = av * 0.2316418882f + 1.0f;
    f32x2 t; t.x = __builtin_amdgcn_rcpf(d.x); t.y = __builtin_amdgcn_rcpf(d.y);
    f32x2 q = t * 0.5307027145f + (-0.7265760135f); q = q * t + 0.7107068705f; q = q * t + (-0.142248368f); q = q * t + 0.127414796f; q = q * t;
    const f32x2 s = (v * v) * (-0.72134752044f);
    f32x2 e; e.x = __builtin_amdgcn_exp2f(s.x); e.y = __builtin_amdgcn_exp2f(s.y);
    const f32x2 m = v * (q * e), r = v - m;
    f32x2 o; o.x = v.x < 0.f ? m.x : r.x; o.y = v.y < 0.f ? m.y : r.y; return o;
}
__device__ __forceinline__ float sigmoid_f(float x) { return __builtin_amdgcn_rcpf(1.0f + __builtin_amdgcn_exp2f(-1.4426950408889634f * x)); }
__device__ __forceinline__ float bf2f(unsigned short b) { return __uint_as_float(((unsigned)b) << 16); }
__device__ __forceinline__ float bflo(unsigned w) { return __uint_as_float(w << 16); }
__device__ __forceinline__ float bfhi(unsigned w) { return __uint_as_float(w & 0xffff0000u); }

template <class Epi, class Sched, bool ALIGN_EPI = false, bool SP2 = false>
__device__ __forceinline__ void gemm_phase(PG8_LAS unsigned char* lds, const Gemm g, const Sched& S, const Epi& E) {
    const int tid = opaque_tid(), wid = __builtin_amdgcn_readfirstlane(tid >> 6), lane = tid & 63, wr = wid >> 2, wc = wid & 3, fr = lane & 15, fq = lane >> 4;
    const int K = g.K, nt = K / BK;
    unsigned voffA[2], voffB[2];
#pragma unroll
    for (int i = 0; i < 2; ++i) { int R, C; stage_rc(tid * 16 + i * 8192, R, C); const int Rb = Epi::PERM ? ((R & ~31) + perm32(R & 31)) : R;
        voffA[i] = (unsigned)(R * g.lda + C) * 2u; voffB[i] = (unsigned)(Rb * g.ldb + C) * 2u; }
    const size_t kstep = (size_t)(BK * 2);
    const size_t hstepA = (size_t)HALF * g.lda * 2, hstepB = (size_t)HALF * g.ldb * 2;
    const size_t tstepA = 2 * hstepA, tstepB = 2 * hstepB;
    const unsigned ldsw = (unsigned)wid * 1024u;
    const int aoff = lds_byte(wr * 64 + fr, fq * 8), boff = lds_byte(wc * 32 + fr, fq * 8);
#define PG8_SA(b, h) (((b) * 2 + (h)) * HTB)
#define PG8_SB(b, h) ((4 + (b) * 2 + (h)) * HTB)
#define PG8_STAGE(bufoff, gbase, voff) do { _Pragma("unroll") for (int _i = 0; _i < 2; ++_i) \
        __builtin_amdgcn_global_load_lds((const unsigned*)((const char*)(gbase) + (voff)[_i]), (PG8_LAS unsigned*)(lds + (bufoff) + ldsw + _i * 8192), 16, 0, 0); } while (0)
#define PG8_LDA(dst, b, h) do { _Pragma("unroll") for (int m = 0; m < 4; ++m) _Pragma("unroll") for (int k = 0; k < 2; ++k) dst[m][k] = *(const PG8_LAS bf16x8*)(lds + PG8_SA(b, h) + aoff + m * 2048 + k * 1024); } while (0)
#define PG8_LDB(dst, b, h) do { _Pragma("unroll") for (int n = 0; n < 2; ++n) _Pragma("unroll") for (int k = 0; k < 2; ++k) dst[n][k] = *(const PG8_LAS bf16x8*)(lds + PG8_SB(b, h) + boff + n * 2048 + k * 1024); } while (0)
#define PG8_MMA(ai, bj, At, Bt) do { __builtin_amdgcn_s_setprio(1); _Pragma("unroll") for (int m = 0; m < 4; ++m) _Pragma("unroll") for (int n = 0; n < 2; ++n) _Pragma("unroll") for (int k = 0; k < 2; ++k) \
        acc[ai][bj][m][n] = __builtin_amdgcn_mfma_f32_16x16x32_bf16(Bt[n][k], At[m][k], acc[ai][bj][m][n], 0, 0, 0); __builtin_amdgcn_s_setprio(0); } while (0)
#define PG8_WAIT_V(n) asm volatile("s_waitcnt vmcnt(" #n ")" ::: "memory")
#define PG8_WAIT_L(n) asm volatile("s_waitcnt lgkmcnt(" #n ")" ::: "memory")
#define PG8_BAR __builtin_amdgcn_s_barrier()
#define PG8_SCHED __builtin_amdgcn_sched_barrier(0)
    Unit cur, nxt; int ui = 0;
    if (!S.next(0, cur)) return;
    f32x4 acc[2][2][4][2];
#pragma unroll
    for (int a = 0; a < 2; ++a)
#pragma unroll
        for (int b = 0; b < 2; ++b)
#pragma unroll
            for (int m = 0; m < 4; ++m)
#pragma unroll
                for (int n = 0; n < 2; ++n) acc[a][b][m][n] = (f32x4){0.f, 0.f, 0.f, 0.f};
    bf16x8 At[4][2], B0[2][2], B1[2][2];
    const char* cA = (const char*)g.A + (size_t)cur.pm * tstepA + (size_t)cur.kz * g.kzstep + (cur.half == 2 ? hstepA : (size_t)0); const char* cB = (const char*)g.Bt + (size_t)cur.pn * tstepB + (size_t)cur.kz * g.kzstep;
    S.a_ready(cur);
    if constexpr (SP2) {
        PG8_STAGE(PG8_SB(0, 0), cB, voffB); PG8_STAGE(PG8_SB(0, 1), cB + hstepB, voffB); PG8_STAGE(PG8_SA(0, 0), cA, voffA); PG8_STAGE(PG8_SA(0, 1), cA + hstepA, voffA);
        if (wr == 1) PG8_BAR;
        PG8_WAIT_V(2); PG8_BAR;
        PG8_STAGE(PG8_SB(1, 0), cB + kstep, voffB); PG8_STAGE(PG8_SA(1, 0), cA + kstep, voffA); PG8_STAGE(PG8_SB(1, 1), cB + hstepB + kstep, voffB);
        PG8_WAIT_V(6); PG8_BAR;
    } else {
        PG8_STAGE(PG8_SB(0, 0), cB, voffB); PG8_STAGE(PG8_SA(0, 0), cA, voffA); PG8_STAGE(PG8_SB(0, 1), cB + hstepB, voffB); PG8_STAGE(PG8_SA(0, 1), cA + hstepA, voffA);
        if (wr == 1) PG8_BAR;
        PG8_WAIT_V(4); PG8_BAR;
        PG8_STAGE(PG8_SB(1, 0), cB + kstep, voffB); PG8_STAGE(PG8_SA(1, 0), cA + kstep, voffA); PG8_STAGE(PG8_SB(1, 1), cB + hstepB + kstep, voffB);
        PG8_WAIT_V(6); PG8_BAR;
    }
    for (;;) {
        const bool has_next = S.next(ui + 1, nxt);
        const char* nA = has_next ? (const char*)g.A + (size_t)nxt.pm * tstepA + (size_t)nxt.kz * g.kzstep + (nxt.half == 2 ? hstepA : (size_t)0) : cA; const char* nB = has_next ? (const char*)g.Bt + (size_t)nxt.pn * tstepB + (size_t)nxt.kz * g.kzstep : cB;
        const bool whole = (cur.half == 0);
        for (int t = 0; t < nt; t += 2) {
            const bool last = (t == nt - 2);
            const char* a1 = cA + (size_t)(t + 1) * kstep;
            const char* a2 = last ? nA : cA + (size_t)(t + 2) * kstep; const char* b2 = last ? nB : cB + (size_t)(t + 2) * kstep;
            const char* a3 = a2 + kstep; const char* b3 = b2 + kstep;
            if (last && has_next) S.a_ready(nxt);
            if constexpr (SP2) {
            PG8_LDB(B0, 0, 0); PG8_LDB(B1, 0, 1); PG8_SCHED; PG8_LDA(At, 0, 0); PG8_STAGE(PG8_SA(1, 1), a1 + hstepA, voffA);
            PG8_WAIT_V(8); PG8_WAIT_L(0); PG8_BAR; PG8_MMA(0, 0, At, B0); PG8_MMA(0, 1, At, B1); PG8_BAR; PG8_SCHED;
            PG8_LDA(At, 0, 1); PG8_STAGE(PG8_SB(0, 0), b2, voffB); PG8_STAGE(PG8_SB(0, 1), b2 + hstepB, voffB); PG8_STAGE(PG8_SA(0, 0), a2, voffA);
            PG8_WAIT_V(8); PG8_WAIT_L(0); PG8_BAR; if (whole) { PG8_MMA(1, 0, At, B0); PG8_MMA(1, 1, At, B1); } PG8_BAR; PG8_SCHED;
            PG8_LDB(B0, 1, 0); PG8_LDB(B1, 1, 1); PG8_SCHED; PG8_LDA(At, 1, 0); PG8_STAGE(PG8_SA(0, 1), a2 + hstepA, voffA);
            PG8_WAIT_V(8); PG8_WAIT_L(0); PG8_BAR; PG8_MMA(0, 0, At, B0); PG8_MMA(0, 1, At, B1); PG8_BAR; PG8_SCHED;
            PG8_LDA(At, 1, 1); PG8_STAGE(PG8_SB(1, 0), b3, voffB); PG8_STAGE(PG8_SB(1, 1), b3 + hstepB, voffB); PG8_STAGE(PG8_SA(1, 0), a3, voffA);
            PG8_WAIT_V(8); PG8_WAIT_L(0); PG8_BAR; if (whole) { PG8_MMA(1, 0, At, B0); PG8_MMA(1, 1, At, B1); } PG8_BAR; PG8_SCHED;
            } else {
            PG8_LDB(B0, 0, 0); PG8_SCHED; PG8_LDA(At, 0, 0); PG8_STAGE(PG8_SA(1, 1), a1 + hstepA, voffA);
            PG8_WAIT_L(8); PG8_BAR; PG8_WAIT_L(0); PG8_MMA(0, 0, At, B0); PG8_BAR; PG8_SCHED;
            PG8_LDB(B1, 0, 1); PG8_STAGE(PG8_SB(0, 0), b2, voffB);
            PG8_BAR; PG8_WAIT_L(0); PG8_MMA(0, 1, At, B1); PG8_BAR;
            PG8_LDA(At, 0, 1); PG8_STAGE(PG8_SA(0, 0), a2, voffA);
            PG8_BAR; PG8_WAIT_L(0); PG8_MMA(1, 0, At, B0); PG8_BAR; PG8_SCHED;
            PG8_STAGE(PG8_SB(0, 1), b2 + hstepB, voffB);
            PG8_WAIT_V(6); PG8_BAR; PG8_MMA(1, 1, At, B1); PG8_BAR;
            PG8_LDB(B0, 1, 0); PG8_SCHED; PG8_LDA(At, 1, 0); PG8_STAGE(PG8_SA(0, 1), a2 + hstepA, voffA);
            PG8_WAIT_L(8); PG8_BAR; PG8_WAIT_L(0); PG8_MMA(0, 0, At, B0); PG8_BAR; PG8_SCHED;
            PG8_LDB(B1, 1, 1); PG8_STAGE(PG8_SB(1, 0), b3, voffB);
            PG8_BAR; PG8_WAIT_L(0); PG8_MMA(0, 1, At, B1); PG8_BAR;
            PG8_LDA(At, 1, 1); PG8_STAGE(PG8_SA(1, 0), a3, voffA);
            PG8_BAR; PG8_WAIT_L(0); PG8_MMA(1, 0, At, B0); PG8_BAR; PG8_SCHED;
            PG8_STAGE(PG8_SB(1, 1), b3 + hstepB, voffB);
            PG8_WAIT_V(6); PG8_BAR; PG8_MMA(1, 1, At, B1); PG8_BAR;
            }
        }
        if constexpr (ALIGN_EPI) { if (wr == 0) PG8_BAR; }
        if constexpr (!Epi::AFTER_DRAIN) { E(acc, cur, wr, wc, fr, fq); S.done(cur); }
        if (!has_next) break;
        if (!Epi::keep_acc(cur)) {
#pragma unroll
        for (int a = 0; a < 2; ++a)
#pragma unroll
            for (int b = 0; b < 2; ++b)
#pragma unroll
                for (int m = 0; m < 4; ++m)
#pragma unroll
                    for (int n = 0; n < 2; ++n) acc[a][b][m][n] = (f32x4){0.f, 0.f, 0.f, 0.f};
        }
        cur = nxt; cA = nA; cB = nB; ++ui;
        if constexpr (ALIGN_EPI) { if (wr == 1) PG8_BAR; }
    }
    PG8_WAIT_V(0);
    if constexpr (!ALIGN_EPI) { if (wr == 0) PG8_BAR; }
    PG8_BAR;
    if constexpr (Epi::AFTER_DRAIN) { E.fused(acc, cur, wr, wc, fr, fq, lds, wid, lane); S.done(cur); }
#undef PG8_SA
#undef PG8_SB
#undef PG8_STAGE
#undef PG8_LDA
#undef PG8_LDB
#undef PG8_MMA
#undef PG8_WAIT_V
#undef PG8_WAIT_L
#undef PG8_BAR
#undef PG8_SCHED
}

constexpr float QSCALE = 0.125f * 1.4426950408889634f;
__device__ __forceinline__ float act_apply1(float v, int act) { return v; }

__device__ __forceinline__ float dpp_xor1(float v) { return __uint_as_float((unsigned)__builtin_amdgcn_mov_dpp((int)__float_as_uint(v), 0xB1, 0xF, 0xF, true)); }
__device__ __forceinline__ float dpp_xor2(float v) { return __uint_as_float((unsigned)__builtin_amdgcn_mov_dpp((int)__float_as_uint(v), 0x4E, 0xF, 0xF, true)); }
__device__ __forceinline__ void quad_transpose(f32x4& r, int li) {
    const bool o1 = (li & 1) != 0, o2 = (li & 2) != 0;
#pragma unroll
    for (int t = 0; t < 2; ++t) { const float a = r[2 * t], b = r[2 * t + 1]; const float rcv = dpp_xor1(o1 ? a : b); r[2 * t] = o1 ? rcv : a; r[2 * t + 1] = o1 ? b : rcv; }
#pragma unroll
    for (int x = 0; x < 2; ++x) { const float a = r[x], b = r[x + 2]; const float rcv = dpp_xor2(o2 ? a : b); r[x] = o2 ? rcv : a; r[x + 2] = o2 ? b : rcv; }
}
struct EpiZ {
    static constexpr bool PERM = true, AFTER_DRAIN = false;
    static __device__ __forceinline__ bool keep_acc(const Unit&) { return false; }
    bf16_t* R1; bf16_t* R2; bf16_t* VT; f32x2* SVST;
    __device__ __forceinline__ void operator()(const f32x4 (&acc)[2][2][4][2], const Unit& u, int wr, int wc, int fr, int fq) const {
        const int kind = u.pn >> 1, half = u.pn & 1;
        const int row0 = u.pm * BM + (u.half == 2 ? HALF : 0) + wr * 64 + fr; const int nai = u.half ? 1 : 2;
        if (kind == 2) {
            const int rowb = u.pm * BM + (u.half == 2 ? HALF : 0) + wr * 64, q = fr >> 2, li = fr & 3;
#pragma unroll
            for (int ai = 0; ai < 2; ++ai) { if (ai >= nai) break;
#pragma unroll
                for (int mp = 0; mp < 2; ++mp) {
                    const int r = rowb + ai * HALF + mp * 32; const int b = r >> 11, sb = (r & 2047) + q * 8;
#pragma unroll
                    for (int bj = 0; bj < 2; ++bj) {
                        const int cv = half * 256 + bj * HALF + wc * 32 + 8 * fq; const int hh = cv >> 7, dv = cv & 127;
#pragma unroll
                        for (int n = 0; n < 2; ++n) {
                            f32x4 x = acc[ai][bj][2 * mp][n], y = acc[ai][bj][2 * mp + 1][n];
                            quad_transpose(x, li); quad_transpose(y, li);
                            u32x4 w; w.x = cvt_pk_bf16(x[0], x[1]); w.y = cvt_pk_bf16(x[2], x[3]); w.z = cvt_pk_bf16(y[0], y[1]); w.w = cvt_pk_bf16(y[2], y[3]);
                            *(u32x4*)(VT + ((size_t)((b * 4 + hh) * 128 + dv + 4 * n + li)) * 2048 + sb) = w;
                        }
                    }
                } }
            return;
        }
        int act = 0; float sc = 1.f; bf16_t* dst = R2; int ld = 2560, cb = 0;
        if (kind == 0) { dst = R1; ld = 1536; cb = 0; sc = QSCALE; }
        else if (kind == 1) { cb = 0; }
        else if (kind == 3) { cb = 512; act = 1; }
        else if (kind == 4) { cb = 1024; }
        else if (kind == 5) { dst = R1; ld = 1536; cb = 512; act = 1; }
        else if (kind == 6) { cb = 1536; act = 2; }
        else if (kind == 7) { cb = 2048; act = 2; }
        else { dst = R1; ld = 1536; cb = 1024; act = 1; }
        const int col0 = cb + half * 256 + wc * 32 + 8 * fq;
#pragma unroll
        for (int ai = 0; ai < 2; ++ai) { if (ai >= nai) break;
#pragma unroll
            for (int m = 0; m < 4; ++m) { bf16_t* rowp = dst + (size_t)(row0 + ai * HALF + m * 16) * ld + col0; float ssum = 0.f, ssq = 0.f;
#pragma unroll
                for (int bj = 0; bj < 2; ++bj) { f32x4 v0 = acc[ai][bj][m][0], v1 = acc[ai][bj][m][1];
                    if (act == 2) { f32x2 a = gelu_pk((f32x2){v0[0], v0[1]}), b = gelu_pk((f32x2){v0[2], v0[3]}), c = gelu_pk((f32x2){v1[0], v1[1]}), d = gelu_pk((f32x2){v1[2], v1[3]});
                        v0 = (f32x4){a.x, a.y, b.x, b.y}; v1 = (f32x4){c.x, c.y, d.x, d.y};
                        if (kind == 7) { ssum += ((v0[0] + v0[1]) + (v0[2] + v0[3])) + ((v1[0] + v1[1]) + (v1[2] + v1[3]));
                            ssq += ((v0[0] * v0[0] + v0[1] * v0[1]) + (v0[2] * v0[2] + v0[3] * v0[3])) + ((v1[0] * v1[0] + v1[1] * v1[1]) + (v1[2] * v1[2] + v1[3] * v1[3])); } }
                    else if (act == 1) {
#pragma unroll
                        for (int e = 0; e < 4; ++e) { v0[e] = v0[e] * sigmoid_f(v0[e]); v1[e] = v1[e] * sigmoid_f(v1[e]); } }
                    v0 = v0 * sc; v1 = v1 * sc; u32x4 w; w.x = cvt_pk_bf16(v0[0], v0[1]); w.y = cvt_pk_bf16(v0[2], v0[3]); w.z = cvt_pk_bf16(v1[0], v1[1]); w.w = cvt_pk_bf16(v1[2], v1[3]);
                    *(u32x4*)(rowp + bj * HALF) = w; }
                if (kind == 7) { ssum += __shfl_xor(ssum, 16); ssum += __shfl_xor(ssum, 32); ssq += __shfl_xor(ssq, 16); ssq += __shfl_xor(ssq, 32);
                    if (fq == 0) SVST[(size_t)(row0 + ai * HALF + m * 16) * 8 + half * 4 + wc] = (f32x2){ssum, ssq}; } } }
    }
};

__device__ __forceinline__ size_t gate_img(int pm, int pn, int wr, int wc, int fr, int fq) { return ((size_t)(pm * 12 + pn) * 8 + (wr * 4 + wc)) * 8192 + (size_t)(fq * 16 + fr) * 8; }
struct EpiGate {
    static constexpr bool PERM = true, AFTER_DRAIN = false;
    static __device__ __forceinline__ bool keep_acc(const Unit&) { return false; }
    bf16_t* O; const float* bias;
    __device__ __forceinline__ void operator()(const f32x4 (&acc)[2][2][4][2], const Unit& u, int wr, int wc, int fr, int fq) const {
        const int col0 = u.pn * BM + wc * 32 + 8 * fq;
        bf16_t* img = O + gate_img(u.pm, u.pn, wr, wc, fr, fq);
        f32x4 bv[2][2];
#pragma unroll
        for (int bj = 0; bj < 2; ++bj)
#pragma unroll
            for (int n = 0; n < 2; ++n) bv[bj][n] = *(const f32x4*)(bias + col0 + bj * HALF + 4 * n);
#pragma unroll
        for (int ai = 0; ai < 2; ++ai)
#pragma unroll
            for (int m = 0; m < 4; ++m)
#pragma unroll
                for (int bj = 0; bj < 2; ++bj) { f32x4 v0 = acc[ai][bj][m][0] + bv[bj][0], v1 = acc[ai][bj][m][1] + bv[bj][1];
#pragma unroll
                    for (int e = 0; e < 4; ++e) { v0[e] = fmaxf(sigmoid_f(v0[e]), 1e-18f); v1[e] = fmaxf(sigmoid_f(v1[e]), 1e-18f); }
                    u32x4 w; w.x = cvt_pk_bf16(v0[0], v0[1]); w.y = cvt_pk_bf16(v0[2], v0[3]); w.z = cvt_pk_bf16(v1[0], v1[1]); w.w = cvt_pk_bf16(v1[2], v1[3]);
                    *(u32x4*)(img + ((ai * 4 + m) * 2 + bj) * 512) = w; }
    }
};

struct EpiMerge {
    static constexpr bool PERM = true, AFTER_DRAIN = false;
    static __device__ __forceinline__ bool keep_acc(const Unit& u) { return u.kz < 2; }
    const bf16_t* G; bf16_t* O;
    __device__ __forceinline__ void operator()(f32x4 (&acc)[2][2][4][2], const Unit& u, int wr, int wc, int fr, int fq) const {
        const int row0 = u.pm * BM + wr * 64 + fr; const int col0 = u.pn * BM + wc * 32 + 8 * fq;
        if (u.kz < 2) {
        const bf16_t* ia = G + gate_img(u.pm, u.kz * 4 + u.pn, wr, wc, fr, fq); const bf16_t* ib = G + gate_img(u.pm, (u.kz + 1) * 4 + u.pn, wr, wc, fr, fq);
#pragma unroll
        for (int ai = 0; ai < 2; ++ai)
#pragma unroll
            for (int m = 0; m < 4; ++m) {
#pragma unroll
                for (int bj = 0; bj < 2; ++bj) { const int idx = ((ai * 4 + m) * 2 + bj) * 512; const u32x4 a = *(const u32x4*)(ia + idx), b = *(const u32x4*)(ib + idx);
                    f32x4 r0, r1;
                    r0[0] = bflo(a.x) * __builtin_amdgcn_rcpf(bflo(b.x)); r0[1] = bfhi(a.x) * __builtin_amdgcn_rcpf(bfhi(b.x));
                    r0[2] = bflo(a.y) * __builtin_amdgcn_rcpf(bflo(b.y)); r0[3] = bfhi(a.y) * __builtin_amdgcn_rcpf(bfhi(b.y));
                    r1[0] = bflo(a.z) * __builtin_amdgcn_rcpf(bflo(b.z)); r1[1] = bfhi(a.z) * __builtin_amdgcn_rcpf(bfhi(b.z));
                    r1[2] = bflo(a.w) * __builtin_amdgcn_rcpf(bflo(b.w)); r1[3] = bfhi(a.w) * __builtin_amdgcn_rcpf(bfhi(b.w));
                    acc[ai][bj][m][0] = acc[ai][bj][m][0] * r0; acc[ai][bj][m][1] = acc[ai][bj][m][1] * r1; }
                if (m == 3) asm volatile("" ::: "memory"); }
        } else {
        const bf16_t* ia = G + gate_img(u.pm, 8 + u.pn, wr, wc, fr, fq);
#pragma unroll
        for (int ai = 0; ai < 2; ++ai)
#pragma unroll
            for (int m = 0; m < 4; ++m) { const size_t r = (size_t)(row0 + ai * HALF + m * 16);
#pragma unroll
                for (int bj = 0; bj < 2; ++bj) { const u32x4 a = *(const u32x4*)(ia + ((ai * 4 + m) * 2 + bj) * 512);
                    f32x4 v0 = acc[ai][bj][m][0], v1 = acc[ai][bj][m][1];
                    v0[0] *= bflo(a.x); v0[1] *= bfhi(a.x); v0[2] *= bflo(a.y); v0[3] *= bfhi(a.y);
                    v1[0] *= bflo(a.z); v1[1] *= bfhi(a.z); v1[2] *= bflo(a.w); v1[3] *= bfhi(a.w);
                    u32x4 w; w.x = cvt_pk_bf16(v0[0], v0[1]); w.y = cvt_pk_bf16(v0[2], v0[3]); w.z = cvt_pk_bf16(v1[0], v1[1]); w.w = cvt_pk_bf16(v1[2], v1[3]);
                    *(u32x4*)(O + r * 1024 + col0 + bj * HALF) = w; } }
        }
    }
};

struct EpiOut {
    static constexpr bool PERM = true, AFTER_DRAIN = false;
    static __device__ __forceinline__ bool keep_acc(const Unit&) { return false; }
    bf16_t* O; float* ssq;
    __device__ __forceinline__ void operator()(const f32x4 (&acc)[2][2][4][2], const Unit& u, int wr, int wc, int fr, int fq) const {
        const int row0 = u.pm * BM + wr * 64 + fr; const int col0 = u.pn * BM + wc * 32 + 8 * fq;
#pragma unroll
        for (int ai = 0; ai < 2; ++ai)
#pragma unroll
            for (int m = 0; m < 4; ++m) { const size_t r = (size_t)(row0 + ai * HALF + m * 16); float s = 0.f;
#pragma unroll
                for (int bj = 0; bj < 2; ++bj) { const f32x4 v0 = acc[ai][bj][m][0], v1 = acc[ai][bj][m][1];
                    s += (v0[0] * v0[0] + v0[1] * v0[1]) + (v0[2] * v0[2] + v0[3] * v0[3]) + (v1[0] * v1[0] + v1[1] * v1[1]) + (v1[2] * v1[2] + v1[3] * v1[3]);
                    u32x4 w; w.x = cvt_pk_bf16(v0[0], v0[1]); w.y = cvt_pk_bf16(v0[2], v0[3]); w.z = cvt_pk_bf16(v1[0], v1[1]); w.w = cvt_pk_bf16(v1[2], v1[3]);
                    *(u32x4*)(O + r * 1024 + col0 + bj * HALF) = w; }
                s += __shfl_xor(s, 16); s += __shfl_xor(s, 32);
                if (fq == 0) ssq[r * 16 + u.pn * 4 + wc] = s; }
    }
};
}

using pg8::bf16_t; using pg8::bf16x8; using pg8::s16x4; using pg8::f32x4; using pg8::f32x2; using pg8::u32x4; using pg8::u32x2;
#define LAS __attribute__((address_space(3)))
constexpr int NWAVES = 8, NTHREADS = 512;
constexpr int BATCH = 8, SEQ = 2048, D = 1024, M = BATCH * SEQ, DEPTH = 2, INW = 4608, GATEW = 3072, BW = 512;
constexpr int R1_LD = 1536, R2_LD = 2560;
constexpr float EPS = 1e-6f;
constexpr size_t MiB = 1u << 20;
constexpr size_t WS_WCAT = 0;
constexpr size_t WCAT_L = (size_t)7680 * 1024;
constexpr size_t WS_WB = 32 * MiB;
constexpr size_t WB_L = (size_t)1024 * 1536;
constexpr size_t WS_WO = 40 * MiB;
constexpr size_t WO_L = (size_t)1024 * 1024;
constexpr size_t WS_PW = 44 * MiB;
constexpr size_t WS_SW = 44 * MiB + 512 * 1024;
constexpr size_t WS_H = 48 * MiB;
constexpr size_t WS_R1 = 80 * MiB;
constexpr size_t WS_R2 = 128 * MiB;
constexpr size_t WS_VT = 208 * MiB;
constexpr size_t WS_GATE = 128 * MiB;
constexpr size_t WS_OUT = 128 * MiB;
constexpr size_t WS_SSQ = 39 * MiB;
constexpr size_t WS_SVST = 45 * MiB;
constexpr size_t WS_CTL = 46 * MiB;
constexpr size_t WS_X1 = 224 * MiB;
constexpr size_t WS_END = 256 * MiB;
constexpr int LDS_BYTES = 132 * 1024;

__device__ __forceinline__ float wave_sum(float v) {
#pragma unroll
    for (int o = 1; o < 64; o <<= 1) v += __shfl_xor(v, o);
    return v;
}
__device__ __forceinline__ unsigned f2bf(float f) { unsigned u = __builtin_bit_cast(unsigned, f); return (u + 0x7fffu + ((u >> 16) & 1u)) >> 16; }
__device__ __forceinline__ unsigned pk2(float lo, float hi) { return f2bf(lo) | (f2bf(hi) << 16); }
#define LDS_WAIT() asm volatile("s_waitcnt lgkmcnt(0)" ::: "memory")

__device__ __forceinline__ void p0_transpose_item(const float* W, int N, bf16_t* WT, int ldo, int col_off, LAS float* scr, int item, int lane) {
    const int nblk = N / 32, kb = item / nblk, nb = item % nblk, k0 = 64 * kb, n0 = 32 * nb;
    float wv[32];
#pragma unroll
    for (int i = 0; i < 32; ++i) { const int kk = 2 * i + (lane >> 5); wv[i] = W[(size_t)(k0 + kk) * N + n0 + (lane & 31)]; }
#pragma unroll
    for (int i = 0; i < 32; ++i) { const int kk = 2 * i + (lane >> 5); scr[kk * 33 + (lane & 31)] = wv[i]; }
    LDS_WAIT(); asm volatile("" ::: "memory");
    const int c = lane & 7;
#pragma unroll
    for (int j = 0; j < 4; ++j) { const int n = (lane >> 3) + 8 * j; const LAS float* s = scr + (8 * c) * 33 + n;
        u32x4 o; o.x = pk2(s[0 * 33], s[1 * 33]); o.y = pk2(s[2 * 33], s[3 * 33]); o.z = pk2(s[4 * 33], s[5 * 33]); o.w = pk2(s[6 * 33], s[7 * 33]);
        *(u32x4*)(WT + (size_t)(n0 + n) * ldo + col_off + k0 + 8 * c) = o; }
    LDS_WAIT(); asm volatile("" ::: "memory");
}
__device__ __forceinline__ void rms_row_to_bf16(const float* xrow, const float* g, bf16_t* orow, int lane) {
    const f32x4* xr = (const f32x4*)xrow + lane; const f32x4* gr = (const f32x4*)g + lane;
    f32x4 v[4]; float s = 0.f;
#pragma unroll
    for (int j = 0; j < 4; ++j) { v[j] = xr[64 * j]; s += (v[j].x * v[j].x + v[j].y * v[j].y) + (v[j].z * v[j].z + v[j].w * v[j].w); }
    const float r = 1.0f / sqrtf(wave_sum(s) * (1.f / D) + EPS);
    u32x2* o8 = (u32x2*)orow + lane;
#pragma unroll
    for (int j = 0; j < 4; ++j) { const f32x4 gg = gr[64 * j]; u32x2 w; w.x = pk2(v[j].x * r * gg.x, v[j].y * r * gg.y); w.y = pk2(v[j].z * r * gg.z, v[j].w * r * gg.w); o8[64 * j] = w; }
}

struct Args {
    const float* x; const float* pre_g; const float* post_g; const float* w_in; const float* lq1; const float* lk1; const float* lq2; const float* lk2;
    const float* subln_g; const float* pool_w; const float* pool_b; const float* pool_scale; const float* sgu_ln_g; const float* sgu_ln_b; const float* sgu_w; const float* sgu_b;
    const float* w_branch; const float* w_merge; const float* b_merge; const float* w_out;
    float* out; unsigned char* ws; int ph_lo, ph_hi;
};

struct P0Args { const float* x; const float* pre_g; const float* w_in; const float* w_merge; const float* w_branch; const float* w_out; const float* pool_w; const float* sgu_w; unsigned char* ws; };
__device__ __forceinline__ void p0_prologue(const P0Args a, LAS unsigned char* lds, int vcu, int G) {
    const int tid = opaque_tid(), lane = tid & 63, wave = __builtin_amdgcn_readfirstlane(tid >> 6);
    LAS float* scr = (LAS float*)(lds + wave * 16384);
    const int gw = vcu * NWAVES + wave, NGW = G * NWAVES;
    bf16_t* WCAT = (bf16_t*)(a.ws + WS_WCAT); bf16_t* WB = (bf16_t*)(a.ws + WS_WB); bf16_t* WO = (bf16_t*)(a.ws + WS_WO); bf16_t* PW = (bf16_t*)(a.ws + WS_PW); bf16_t* SW = (bf16_t*)(a.ws + WS_SW);
    constexpr int I_IN = 16 * (INW / 32), I_MG = 16 * (GATEW / 32), I_BR = 8 * (D / 32), I_WO = 16 * (D / 32), I_PW = 2 * 4;
    constexpr int PER_L = I_IN + I_MG + 3 * I_BR + I_WO + 4 * I_PW;
    for (int it = gw; it < DEPTH * PER_L; it += NGW) {
        const int l = it / PER_L; int r = it % PER_L;
        if (r < I_IN) { p0_transpose_item(a.w_in + (size_t)l * D * INW, INW, WCAT + l * WCAT_L, 1024, 0, scr, r, lane); continue; } r -= I_IN;
        if (r < I_MG) { p0_transpose_item(a.w_merge + (size_t)l * D * GATEW, GATEW, WCAT + l * WCAT_L + (size_t)INW * 1024, 1024, 0, scr, r, lane); continue; } r -= I_MG;
        if (r < 3 * I_BR) { const int n = r / I_BR; p0_transpose_item(a.w_branch + ((size_t)l * 3 + n) * BW * D, D, WB + l * WB_L, 1536, n * 512, scr, r % I_BR, lane); continue; } r -= 3 * I_BR;
        if (r < I_WO) { p0_transpose_item(a.w_out + (size_t)l * D * D, D, WO + l * WO_L, 1024, 0, scr, r, lane); continue; } r -= I_WO;
        { const int g = r / I_PW; p0_transpose_item(a.pool_w + ((size_t)l * 4 + g) * 128 * 128, 128, PW + ((size_t)l * 4 + g) * 128 * 128, 128, 0, scr, r % I_PW, lane); }
    }
    for (int e = gw * 64 + lane; e < DEPTH * 4 * 128 * 128; e += NGW * 64) { const int j = e & 127, i = (e >> 7) & 127; const float v = a.sgu_w[e]; SW[e] = (bf16_t)f2bf(((j >> 6) <= (i >> 6)) ? v : 0.f); }
    bf16_t* H = (bf16_t*)(a.ws + WS_H);
    for (int m = gw; m < M; m += NGW) rms_row_to_bf16(a.x + (size_t)m * D, a.pre_g, H + (size_t)m * D, lane);
}

template <bool XIN_BF, bool XOUT_BF>
__device__ __forceinline__ void p5_rows(const void* xin_, const bf16_t* outb, const float* ssq, const float* post_g, const float* pre_g_next, void* xout_, bf16_t* H, int vcu, int G) {
    const int tid = opaque_tid(), lane = tid & 63, wave = __builtin_amdgcn_readfirstlane(tid >> 6);
    const int gw = vcu * NWAVES + wave, NGW = G * NWAVES;
    f32x4 pgv[4], grv[4];
#pragma unroll
    for (int j = 0; j < 4; ++j) { pgv[j] = ((const f32x4*)post_g + lane)[64 * j]; grv[j] = pre_g_next ? ((const f32x4*)pre_g_next + lane)[64 * j] : (f32x4){0.f, 0.f, 0.f, 0.f}; }
    for (int m0 = gw; m0 < M; m0 += 2 * NGW) {
        const int m1r = m0 + NGW; const bool has1 = m1r < M; const int m1 = has1 ? m1r : m0;
        f32x4 va[4], vb[4]; float sa = 0.f, sb2 = 0.f;
        { const f32x4* spa = (const f32x4*)(ssq + (size_t)m0 * 16); const f32x4* spb = (const f32x4*)(ssq + (size_t)m1 * 16);
          const f32x4 a0 = spa[0], a1 = spa[1], a2 = spa[2], a3 = spa[3], b0 = spb[0], b1 = spb[1], b2 = spb[2], b3 = spb[3];
          const float ssa = ((a0.x + a0.y) + (a0.z + a0.w)) + ((a1.x + a1.y) + (a1.z + a1.w)) + ((a2.x + a2.y) + (a2.z + a2.w)) + ((a3.x + a3.y) + (a3.z + a3.w));
          const float ssb = ((b0.x + b0.y) + (b0.z + b0.w)) + ((b1.x + b1.y) + (b1.z + b1.w)) + ((b2.x + b2.y) + (b2.z + b2.w)) + ((b3.x + b3.y) + (b3.z + b3.w));
          const float ra = 1.0f / sqrtf(ssa * (1.f / D) + EPS), rb = 1.0f / sqrtf(ssb * (1.f / D) + EPS);
          const u32x2* oa = (const u32x2*)(outb + (size_t)m0 * D) + lane; const u32x2* ob = (const u32x2*)(outb + (size_t)m1 * D) + lane;
#pragma unroll
          for (int j = 0; j < 4; ++j) { const f32x4 gv = pgv[j]; f32x4 xva, xvb;
              if (XIN_BF) { const u32x2 wa_ = ((const u32x2*)((const bf16_t*)xin_ + (size_t)m0 * D) + lane)[64 * j], wb_ = ((const u32x2*)((const bf16_t*)xin_ + (size_t)m1 * D) + lane)[64 * j];
                  xva = (f32x4){pg8::bflo(wa_.x), pg8::bfhi(wa_.x), pg8::bflo(wa_.y), pg8::bfhi(wa_.y)}; xvb = (f32x4){pg8::bflo(wb_.x), pg8::bfhi(wb_.x), pg8::bflo(wb_.y), pg8::bfhi(wb_.y)}; }
              else { xva = ((const f32x4*)((const float*)xin_ + (size_t)m0 * D) + lane)[64 * j]; xvb = ((const f32x4*)((const float*)xin_ + (size_t)m1 * D) + lane)[64 * j]; }
              const u32x2 owa = oa[64 * j], owb = ob[64 * j];
              const f32x4 ova = (f32x4){pg8::bflo(owa.x), pg8::bfhi(owa.x), pg8::bflo(owa.y), pg8::bfhi(owa.y)}, ovb = (f32x4){pg8::bflo(owb.x), pg8::bfhi(owb.x), pg8::bflo(owb.y), pg8::bfhi(owb.y)};
              va[j] = xva + ova * ra * gv; vb[j] = xvb + ovb * rb * gv;
              sa += (va[j].x * va[j].x + va[j].y * va[j].y) + (va[j].z * va[j].z + va[j].w * va[j].w); sb2 += (vb[j].x * vb[j].x + vb[j].y * vb[j].y) + (vb[j].z * vb[j].z + vb[j].w * vb[j].w); } }
        if (XOUT_BF) { u32x2* xoa = (u32x2*)((bf16_t*)xout_ + (size_t)m0 * D) + lane; u32x2* xob = (u32x2*)((bf16_t*)xout_ + (size_t)m1 * D) + lane;
#pragma unroll
            for (int j = 0; j < 4; ++j) { u32x2 wa_, wb_; wa_.x = pg8::cvt_pk_bf16(va[j].x, va[j].y); wa_.y = pg8::cvt_pk_bf16(va[j].z, va[j].w); wb_.x = pg8::cvt_pk_bf16(vb[j].x, vb[j].y); wb_.y = pg8::cvt_pk_bf16(vb[j].z, vb[j].w);
                xoa[64 * j] = wa_; if (has1) xob[64 * j] = wb_; } }
        else { f32x4* xoa = (f32x4*)((float*)xout_ + (size_t)m0 * D) + lane; f32x4* xob = (f32x4*)((float*)xout_ + (size_t)m1 * D) + lane;
#pragma unroll
            for (int j = 0; j < 4; ++j) { xoa[64 * j] = va[j]; if (has1) xob[64 * j] = vb[j]; } }
        if (pre_g_next) {
            const float r2a = 1.0f / sqrtf(wave_sum(sa) * (1.f / D) + EPS), r2b = 1.0f / sqrtf(wave_sum(sb2) * (1.f / D) + EPS);
            u32x2* o8a = (u32x2*)(H + (size_t)m0 * D) + lane; u32x2* o8b = (u32x2*)(H + (size_t)m1 * D) + lane;
#pragma unroll
            for (int j = 0; j < 4; ++j) { const f32x4 gg = grv[j]; u32x2 wa, wb; wa.x = pg8::cvt_pk_bf16(va[j].x * r2a * gg.x, va[j].y * r2a * gg.y); wa.y = pg8::cvt_pk_bf16(va[j].z * r2a * gg.z, va[j].w * r2a * gg.w);
                wb.x = pg8::cvt_pk_bf16(vb[j].x * r2b * gg.x, vb[j].y * r2b * gg.y); wb.y = pg8::cvt_pk_bf16(vb[j].z * r2b * gg.z, vb[j].w * r2b * gg.w); o8a[64 * j] = wa; if (has1) o8b[64 * j] = wb; }
        }
    }
}

#define MFMA16(a, b, c) __builtin_amdgcn_mfma_f32_16x16x32_bf16((a), (b), (c), 0, 0, 0)
constexpr int ASTG = 32768;
__device__ __forceinline__ bf16x8 pack8(const f32x4& a, const f32x4& b) {
    u32x4 w; w.x = pg8::cvt_pk_bf16(a[0], a[1]); w.y = pg8::cvt_pk_bf16(a[2], a[3]); w.z = pg8::cvt_pk_bf16(b[0], b[1]); w.w = pg8::cvt_pk_bf16(b[2], b[3]);
    return __builtin_bit_cast(bf16x8, w);
}
__device__ __forceinline__ float xmax32(float v) { auto rr = __builtin_amdgcn_permlane32_swap(__float_as_uint(v), __float_as_uint(v), false, false); return fmaxf(__uint_as_float(rr[0]), __uint_as_float(rr[1])); }
__device__ __forceinline__ float xmax16(float v) { auto rr = __builtin_amdgcn_permlane16_swap(__float_as_uint(v), __float_as_uint(v), false, false); return fmaxf(__uint_as_float(rr[0]), __uint_as_float(rr[1])); }
__device__ __forceinline__ void swap16x4(f32x4& a, f32x4& b) {
#pragma unroll
    for (int j = 0; j < 4; ++j) { auto r = __builtin_amdgcn_permlane16_swap(__float_as_uint(a[j]), __float_as_uint(b[j]), false, false); a[j] = __uint_as_float(r[0]); b[j] = __uint_as_float(r[1]); }
}
__device__ __forceinline__ void attn_unit(int b, int h, int qb, bf16_t* R1, const bf16_t* R2, const bf16_t* VT, const float* subln_g, float lam, float one_m_lam_init, LAS unsigned char* lds, bool do_store) {
    const int tid = opaque_tid(), lane = tid & 63, wid = __builtin_amdgcn_readfirstlane(tid >> 6), fr = lane & 15, fq = lane >> 4;
    const size_t tok0 = (size_t)b * SEQ;
    const int qrow = qb * 128 + wid * 16 + fr;
    bf16x8 qf[2][2];
    { const bf16_t* qp = R1 + (tok0 + qrow) * R1_LD + h * 128 + fq * 8;
#pragma unroll
      for (int m = 0; m < 2; ++m)
#pragma unroll
        for (int ks = 0; ks < 2; ++ks) qf[m][ks] = *(const bf16x8*)(qp + m * 64 + ks * 32); }
    const bf16_t* ksrc[2]; const bf16_t* vsrc[2];
#pragma unroll
    for (int i = 0; i < 2; ++i) { const int j = wid + 8 * i; const int kr = 4 * j + (lane >> 4), vr = 8 * j + (lane >> 3);
        ksrc[i] = R2 + (tok0 + kr) * R2_LD + h * 128 + (((lane & 15) ^ (kr & 15)) * 8);
        vsrc[i] = VT + ((size_t)((b * 4 + h) * 128 + vr)) * SEQ + (((lane & 7) ^ ((vr >> 1) & 7)) * 8); }
#define ATT_DMA(T_, stage) do { _Pragma("unroll") for (int u_ = 0; u_ < 2; ++u_) _Pragma("unroll") for (int i_ = 0; i_ < 2; ++i_) { \
        __builtin_amdgcn_global_load_lds((const unsigned*)(ksrc[i_] + (size_t)(2 * (T_) + u_) * 64 * R2_LD), (LAS unsigned*)(lds + (stage) * 65536 + u_ * ASTG + (wid + 8 * i_) * 1024), 16, 0, 0); \
        __builtin_amdgcn_global_load_lds((const unsigned*)(vsrc[i_] + (2 * (T_) + u_) * 64), (LAS unsigned*)(lds + (stage) * 65536 + u_ * ASTG + 16384 + (wid + 8 * i_) * 1024), 16, 0, 0); } } while (0)
    const int ND = qb + 1;
    if (wid >= 4) __builtin_amdgcn_s_setprio(1);
    ATT_DMA(0, 0);
    f32x4 o[2][8];
#pragma unroll
    for (int m = 0; m < 2; ++m)
#pragma unroll
        for (int nb = 0; nb < 8; ++nb) o[m][nb] = (f32x4){0.f, 0.f, 0.f, 0.f};
    float mrun[2] = {0.f, 0.f}, lrun[2] = {0.f, 0.f};
    int koff[2][2], voff[2];
#pragma unroll
    for (int m = 0; m < 2; ++m)
#pragma unroll
        for (int ks = 0; ks < 2; ++ks) koff[m][ks] = fr * 256 + (((m * 8 + ks * 4 + fq) ^ fr) * 16);
#pragma unroll
    for (int s2 = 0; s2 < 2; ++s2) voff[s2] = 16384 + fr * 128 + (((4 * s2 + fq) ^ ((fr >> 1) & 7)) * 16);
    asm volatile("s_waitcnt vmcnt(0)" ::: "memory"); __builtin_amdgcn_s_barrier(); asm volatile("" ::: "memory");
    for (int T = 0; T < ND; ++T) {
        const LAS unsigned char* sb = lds + (T & 1) * 65536;
        const bool skip2 = (T == ND - 1) && (wid < 4);
        bf16x8 pb[2][4];
#pragma unroll
        for (int m = 0; m < 2; ++m) {
            f32x4 s[2][4];
            const f32x4 negm = (f32x4){-mrun[m], -mrun[m], -mrun[m], -mrun[m]};
#define KFRAG(u_, j) (*(const LAS bf16x8*)(sb + (u_) * ASTG + ((j) >> 1) * 4096 + koff[m][(j) & 1]))
            __builtin_amdgcn_sched_barrier(0);
            { bf16x8 kf[4]; kf[0] = KFRAG(0, 0); kf[1] = KFRAG(0, 1); kf[2] = KFRAG(0, 2);
#pragma unroll
              for (int j = 0; j < 8; ++j) { const int kb = j >> 1, ks = j & 1;
                  if (j + 3 < 8) kf[(j + 3) & 3] = KFRAG(0, j + 3);
                  s[0][kb] = MFMA16(kf[j & 3], qf[m][ks], ks == 0 ? negm : s[0][kb]); }
              __builtin_amdgcn_sched_group_barrier(0x100, 3, 0);
#pragma unroll
              for (int j = 0; j < 5; ++j) { __builtin_amdgcn_sched_group_barrier(0x008, 1, 0); __builtin_amdgcn_sched_group_barrier(0x100, 1, 0); }
              __builtin_amdgcn_sched_group_barrier(0x008, 3, 0);
              __builtin_amdgcn_sched_barrier(0); }
            if (!skip2) {
                bf16x8 kf[4]; kf[0] = KFRAG(1, 0); kf[1] = KFRAG(1, 1); kf[2] = KFRAG(1, 2);
#pragma unroll
                for (int j = 0; j < 8; ++j) { const int kb = j >> 1, ks = j & 1;
                    if (j + 3 < 8) kf[(j + 3) & 3] = KFRAG(1, j + 3);
                    s[1][kb] = MFMA16(kf[j & 3], qf[m][ks], ks == 0 ? negm : s[1][kb]); }
                __builtin_amdgcn_sched_group_barrier(0x100, 3, 0);
#pragma unroll
                for (int j = 0; j < 5; ++j) { __builtin_amdgcn_sched_group_barrier(0x008, 1, 0); __builtin_amdgcn_sched_group_barrier(0x100, 1, 0); }
                __builtin_amdgcn_sched_group_barrier(0x008, 3, 0);
                __builtin_amdgcn_sched_barrier(0);
            } else {
#pragma unroll
                for (int kb = 0; kb < 4; ++kb) s[1][kb] = (f32x4){-1e30f, -1e30f, -1e30f, -1e30f};
            }
#undef KFRAG
            float mx = -1e30f;
#pragma unroll
            for (int u = 0; u < 2; ++u)
#pragma unroll
                for (int kb = 0; kb < 4; ++kb) { mx = __builtin_fmaxf(__builtin_fmaxf(mx, s[u][kb][0]), s[u][kb][1]); mx = __builtin_fmaxf(__builtin_fmaxf(mx, s[u][kb][2]), s[u][kb][3]); }
            mx = xmax16(mx); mx = xmax32(mx);
            if (T == 0 || __any(mx > 8.0f)) {
                const float dl = (T == 0) ? mx : fmaxf(mx, 0.f), f = __builtin_amdgcn_exp2f(-dl);
                mrun[m] += dl; lrun[m] *= f;
#pragma unroll
                for (int u = 0; u < 2; ++u)
#pragma unroll
                    for (int kb = 0; kb < 4; ++kb) s[u][kb] = s[u][kb] - dl;
#pragma unroll
                for (int nb = 0; nb < 8; ++nb) o[m][nb] = o[m][nb] * f;
            }
            float ps = 0.f;
#pragma unroll
            for (int u = 0; u < 2; ++u)
#pragma unroll
                for (int kb = 0; kb < 4; ++kb)
#pragma unroll
                    for (int j = 0; j < 4; ++j) { const float p = __builtin_amdgcn_exp2f(s[u][kb][j]); s[u][kb][j] = p; ps += p; }
            lrun[m] += ps;
#pragma unroll
            for (int u = 0; u < 2; ++u) { pb[m][2 * u] = pack8(s[u][0], s[u][1]); pb[m][2 * u + 1] = pack8(s[u][2], s[u][3]); }
        }
        if (T + 1 < ND) ATT_DMA(T + 1, (T + 1) & 1);
#pragma unroll
        for (int u = 0; u < 2; ++u) {
            if (u == 1 && skip2) continue;
            __builtin_amdgcn_sched_barrier(0);
            const LAS unsigned char* vb_ = sb + u * ASTG;
#define VFRAG(j) (*(const LAS bf16x8*)(vb_ + ((j) >> 1) * 2048 + voff[(j) & 1]))
            bf16x8 vf[4]; vf[0] = VFRAG(0); vf[1] = VFRAG(1); vf[2] = VFRAG(2);
#pragma unroll
            for (int j = 0; j < 16; ++j) { const int nb = j >> 1, s2 = j & 1;
                if (j + 3 < 16) vf[(j + 3) & 3] = VFRAG(j + 3);
                o[0][nb] = MFMA16(vf[j & 3], pb[0][2 * u + s2], o[0][nb]); o[1][nb] = MFMA16(vf[j & 3], pb[1][2 * u + s2], o[1][nb]);
            }
#undef VFRAG
            __builtin_amdgcn_sched_group_barrier(0x100, 3, 0);
#pragma unroll
            for (int j = 0; j < 13; ++j) { __builtin_amdgcn_sched_group_barrier(0x008, 2, 0); __builtin_amdgcn_sched_group_barrier(0x100, 1, 0); }
            __builtin_amdgcn_sched_group_barrier(0x008, 6, 0);
            __builtin_amdgcn_sched_barrier(0);
        }
        asm volatile("s_waitcnt vmcnt(0)" ::: "memory");
        __builtin_amdgcn_s_barrier(); asm volatile("" ::: "memory");
    }
#undef ATT_DMA
    __builtin_amdgcn_s_setprio(0);
    float l0 = lrun[0], l1 = lrun[1];
    l0 += __shfl_xor(l0, 16); l0 += __shfl_xor(l0, 32); l1 += __shfl_xor(l1, 16); l1 += __shfl_xor(l1, 32);
    const float i0 = 1.0f / l0, i1 = lam / l1;
    float ss = 0.f;
#pragma unroll
    for (int nb = 0; nb < 8; ++nb) { o[0][nb] = o[0][nb] * i0 - o[1][nb] * i1; ss += (o[0][nb][0] * o[0][nb][0] + o[0][nb][1] * o[0][nb][1]) + (o[0][nb][2] * o[0][nb][2] + o[0][nb][3] * o[0][nb][3]); }
    ss += __shfl_xor(ss, 16); ss += __shfl_xor(ss, 32);
    const float rr = one_m_lam_init / sqrtf(ss * (1.f / 128.f) + EPS);
    const int cst = 16 * (fq & 1) + 8 * (fq >> 1);
    const bf16_t* gap = R2 + (tok0 + qrow) * R2_LD + 512 + h * 128 + cst;
    bf16_t* yp = R1 + (tok0 + qrow) * R1_LD + h * 128 + cst;
#pragma unroll
    for (int p = 0; p < 4; ++p) { const u32x4 g4 = *(const u32x4*)(gap + p * 32);
        const f32x4 sa = *(const f32x4*)(subln_g + (2 * p) * 16 + fq * 4), sb = *(const f32x4*)(subln_g + (2 * p + 1) * 16 + fq * 4);
        f32x4 a = o[0][2 * p] * rr * sa, b = o[0][2 * p + 1] * rr * sb;
        swap16x4(a, b);
        u32x4 w; w.x = pg8::cvt_pk_bf16(a[0] * pg8::bflo(g4.x), a[1] * pg8::bfhi(g4.x)); w.y = pg8::cvt_pk_bf16(a[2] * pg8::bflo(g4.y), a[3] * pg8::bfhi(g4.y));
        w.z = pg8::cvt_pk_bf16(b[0] * pg8::bflo(g4.z), b[1] * pg8::bfhi(g4.z)); w.w = pg8::cvt_pk_bf16(b[2] * pg8::bflo(g4.w), b[3] * pg8::bfhi(g4.w));
        if (do_store) *(u32x4*)(yp + p * 32) = w; }
}

constexpr int MSTR = 272, MBUF = 128 * MSTR;
__device__ __forceinline__ void mix_gemm(const LAS unsigned char* la, const LAS unsigned char* lb, f32x4 (&acc)[4][2], int wr, int wc, int fr, int fq) {
#pragma unroll
    for (int mi = 0; mi < 4; ++mi)
#pragma unroll
        for (int ni = 0; ni < 2; ++ni) acc[mi][ni] = (f32x4){0.f, 0.f, 0.f, 0.f};
#pragma unroll
    for (int ks = 0; ks < 4; ++ks) {
        bf16x8 bfr[2], afr[4];
#pragma unroll
        for (int ni = 0; ni < 2; ++ni) bfr[ni] = *(const LAS bf16x8*)(lb + (wc * 32 + ni * 16 + fr) * MSTR + ks * 64 + fq * 16);
#pragma unroll
        for (int mi = 0; mi < 4; ++mi) afr[mi] = *(const LAS bf16x8*)(la + (wr * 64 + mi * 16 + fr) * MSTR + ks * 64 + fq * 16);
#pragma unroll
        for (int mi = 0; mi < 4; ++mi)
#pragma unroll
            for (int ni = 0; ni < 2; ++ni) acc[mi][ni] = MFMA16(bfr[ni], afr[mi], acc[mi][ni]);
    }
}

__device__ __forceinline__ void pool_unit(int tb, int g, bf16_t* R1, const bf16_t* R2, const bf16_t* PWl, const float* pool_b, const float* pool_scale, LAS unsigned char* lds, bool do_store) {
    const int tid = opaque_tid(), lane = tid & 63, wid = __builtin_amdgcn_readfirstlane(tid >> 6), fr = lane & 15, fq = lane >> 4, wr = wid >> 2, wc = wid & 3;
    LAS unsigned char* la = lds; LAS unsigned char* lb = lds + MBUF; LAS unsigned char* lp = lds + 2 * MBUF;
    const int W = 2 << g; const int t0 = tb * 128; const bool first = (t0 & (SEQ - 1)) == 0;
    const int cst = wc * 32 + 16 * (fq & 1) + 8 * (fq >> 1);
    u32x4 ggv[4]; f32x4 pbv[2], scv[2];
#pragma unroll
    for (int ni = 0; ni < 2; ++ni) { const int col = g * 128 + wc * 32 + ni * 16 + fq * 4; pbv[ni] = *(const f32x4*)(pool_b + col); scv[ni] = *(const f32x4*)(pool_scale + col); }
#pragma unroll
    for (int mi = 0; mi < 4; ++mi) ggv[mi] = *(const u32x4*)(R1 + (size_t)(tb * 128 + wr * 64 + mi * 16 + fr) * R1_LD + 512 + g * 128 + cst);
#pragma unroll
    for (int i = 0; i < 4; ++i) { const int p = tid + 512 * i, row = p >> 4, ch = p & 15;
        *(LAS u32x4*)(lb + row * MSTR + ch * 16) = *(const u32x4*)(PWl + (size_t)g * 128 * 128 + row * 128 + ch * 8); }
#pragma unroll
    for (int i = 0; i < 5; ++i) { const int p = tid + 512 * i, row = p >> 4, ch = p & 15;
        if (row < 143) { u32x4 v = (u32x4){0u, 0u, 0u, 0u}; if (!(first && row < 15)) v = *(const u32x4*)(R2 + (size_t)(t0 - 15 + row) * R2_LD + 1024 + g * 128 + ch * 8);
            *(LAS u32x4*)(lp + row * MSTR + ch * 16) = v; } }
    __syncthreads();
    { const int tg = tid >> 4, ch = tid & 15, T0 = 4 * tg; const int s0 = (t0 + T0) & (SEQ - 1);
      const LAS unsigned char* src = lp + (T0 + 15) * MSTR + ch * 16;
      float a[8];
#pragma unroll
      for (int e = 0; e < 8; ++e) a[e] = 0.f;
      u32x4 w = (u32x4){0u, 0u, 0u, 0u};
      for (int k = W - 1; k >= 0; --k) { w = *(const LAS u32x4*)(src - k * MSTR);
          a[0] += pg8::bflo(w.x); a[1] += pg8::bfhi(w.x); a[2] += pg8::bflo(w.y); a[3] += pg8::bfhi(w.y); a[4] += pg8::bflo(w.z); a[5] += pg8::bfhi(w.z); a[6] += pg8::bflo(w.w); a[7] += pg8::bfhi(w.w); }
#pragma unroll
      for (int d = 0; d < 4; ++d) {
          if (d > 0) { w = *(const LAS u32x4*)(src + d * MSTR); const u32x4 wo = *(const LAS u32x4*)(src + (d - W) * MSTR);
              a[0] += pg8::bflo(w.x) - pg8::bflo(wo.x); a[1] += pg8::bfhi(w.x) - pg8::bfhi(wo.x); a[2] += pg8::bflo(w.y) - pg8::bflo(wo.y); a[3] += pg8::bfhi(w.y) - pg8::bfhi(wo.y);
              a[4] += pg8::bflo(w.z) - pg8::bflo(wo.z); a[5] += pg8::bfhi(w.z) - pg8::bfhi(wo.z); a[6] += pg8::bflo(w.w) - pg8::bflo(wo.w); a[7] += pg8::bfhi(w.w) - pg8::bfhi(wo.w); }
          const int sd = s0 + d; const int cnt = (sd + 1 < W) ? (sd + 1) : W; const float ic = 1.0f / (float)cnt;
          u32x4 ov; ov.x = pg8::cvt_pk_bf16(a[0] * ic - pg8::bflo(w.x), a[1] * ic - pg8::bfhi(w.x)); ov.y = pg8::cvt_pk_bf16(a[2] * ic - pg8::bflo(w.y), a[3] * ic - pg8::bfhi(w.y));
          ov.z = pg8::cvt_pk_bf16(a[4] * ic - pg8::bflo(w.z), a[5] * ic - pg8::bfhi(w.z)); ov.w = pg8::cvt_pk_bf16(a[6] * ic - pg8::bflo(w.w), a[7] * ic - pg8::bfhi(w.w));
          *(LAS u32x4*)(la + (T0 + d) * MSTR + ch * 16) = ov; } }
    __syncthreads();
    f32x4 acc[4][2];
    mix_gemm(la, lb, acc, wr, wc, fr, fq);
#pragma unroll
    for (int mi = 0; mi < 4; ++mi) { const int t = tb * 128 + wr * 64 + mi * 16 + fr;
        f32x4 a = (acc[mi][0] + pbv[0]) * scv[0], b = (acc[mi][1] + pbv[1]) * scv[1];
        swap16x4(a, b);
        const u32x4 g4 = ggv[mi];
        u32x4 w; w.x = pg8::cvt_pk_bf16(a[0] * pg8::bflo(g4.x), a[1] * pg8::bfhi(g4.x)); w.y = pg8::cvt_pk_bf16(a[2] * pg8::bflo(g4.y), a[3] * pg8::bfhi(g4.y));
        w.z = pg8::cvt_pk_bf16(b[0] * pg8::bflo(g4.z), b[1] * pg8::bfhi(g4.z)); w.w = pg8::cvt_pk_bf16(b[2] * pg8::bflo(g4.w), b[3] * pg8::bfhi(g4.w));
        if (do_store) *(u32x4*)(R1 + (size_t)t * R1_LD + 512 + g * 128 + cst) = w; }
    __syncthreads();
}

__device__ __forceinline__ void sgu_unit(int tb, int g, bf16_t* R1, const bf16_t* R2, const bf16_t* SWl, const float* ln_g, const float* ln_b, const float* sgu_b, const f32x2* SVST, LAS unsigned char* lds, bool do_store) {
    const int tid = opaque_tid(), lane = tid & 63, wid = __builtin_amdgcn_readfirstlane(tid >> 6), fr = lane & 15, fq = lane >> 4, wr = wid >> 2, wc = wid & 3;
    LAS unsigned char* la = lds; LAS unsigned char* lb = lds + MBUF;
    const int cst = wc * 32 + 16 * (fq & 1) + 8 * (fq >> 1);
    u32x4 ggv[4], uuv[4]; float bsv[4];
#pragma unroll
    for (int mi = 0; mi < 4; ++mi) { const int ipos = wr * 64 + mi * 16 + fr; bsv[mi] = sgu_b[g * 128 + ipos]; const size_t t = (size_t)(tb * 128 + ipos);
        ggv[mi] = *(const u32x4*)(R1 + t * R1_LD + 1024 + g * 128 + cst); uuv[mi] = *(const u32x4*)(R2 + t * R2_LD + 1536 + g * 128 + cst); }
    LAS f32x2* st = (LAS f32x2*)(lds + 2 * MBUF);
    if (tid < 128) { const f32x4* sp = (const f32x4*)(SVST + (size_t)(tb * 128 + tid) * 8); const f32x4 a0 = sp[0], a1 = sp[1], a2 = sp[2], a3 = sp[3];
        const float m0 = ((a0.x + a0.z) + (a1.x + a1.z) + (a2.x + a2.z) + (a3.x + a3.z)) * (1.f / 512.f), q0 = ((a0.y + a0.w) + (a1.y + a1.w) + (a2.y + a2.w) + (a3.y + a3.w)) * (1.f / 512.f);
        st[tid] = (f32x2){m0, 1.0f / sqrtf(fmaxf(q0 - m0 * m0, 0.f) + EPS)}; }
#pragma unroll
    for (int i = 0; i < 4; ++i) { const int p = tid + 512 * i, row = p >> 4, ch = p & 15;
        *(LAS u32x4*)(la + row * MSTR + ch * 16) = *(const u32x4*)(SWl + (size_t)g * 128 * 128 + row * 128 + ch * 8); }
    u32x4 rw[2][2];
#pragma unroll
    for (int i = 0; i < 2; ++i) { const int ci = i * 8 + wid, tp = (ci & 3) * 16 + (lane & 15), ch = (ci >> 2) * 4 + (lane >> 4);
        const bf16_t* src = R2 + (size_t)(tb * 128 + 2 * tp) * R2_LD + 2048 + g * 128 + ch * 8;
        rw[i][0] = *(const u32x4*)src; rw[i][1] = *(const u32x4*)(src + R2_LD); }
    __syncthreads();
#pragma unroll
    for (int i = 0; i < 2; ++i) { const int ci = i * 8 + wid, tp = (ci & 3) * 16 + (lane & 15), ch = (ci >> 2) * 4 + (lane >> 4);
        const u32x4 w0 = rw[i][0], w1 = rw[i][1];
        const f32x2 ms0 = st[2 * tp], ms1 = st[2 * tp + 1];
        const f32x4 g0 = *(const f32x4*)(ln_g + g * 128 + ch * 8), g1 = *(const f32x4*)(ln_g + g * 128 + ch * 8 + 4), b0 = *(const f32x4*)(ln_b + g * 128 + ch * 8), b1 = *(const f32x4*)(ln_b + g * 128 + ch * 8 + 4);
        const float va[8] = {pg8::bflo(w0.x), pg8::bfhi(w0.x), pg8::bflo(w0.y), pg8::bfhi(w0.y), pg8::bflo(w0.z), pg8::bfhi(w0.z), pg8::bflo(w0.w), pg8::bfhi(w0.w)};
        const float vb[8] = {pg8::bflo(w1.x), pg8::bfhi(w1.x), pg8::bflo(w1.y), pg8::bfhi(w1.y), pg8::bflo(w1.z), pg8::bfhi(w1.z), pg8::bflo(w1.w), pg8::bfhi(w1.w)};
#pragma unroll
        for (int e = 0; e < 8; ++e) { const float gg = e < 4 ? g0[e & 3] : g1[e & 3], bb = e < 4 ? b0[e & 3] : b1[e & 3];
            *(LAS unsigned*)(lb + (ch * 8 + e) * MSTR + tp * 4) = pg8::cvt_pk_bf16((va[e] - ms0.x) * ms0.y * gg + bb, (vb[e] - ms1.x) * ms1.y * gg + bb); } }
    __syncthreads();
    f32x4 acc[4][2];
    mix_gemm(la, lb, acc, wr, wc, fr, fq);
#pragma unroll
    for (int mi = 0; mi < 4; ++mi) { const int ipos = wr * 64 + mi * 16 + fr, t = tb * 128 + ipos; const float bs = bsv[mi];
        f32x4 a = acc[mi][0] + bs, b = acc[mi][1] + bs;
        swap16x4(a, b);
        const u32x4 g4 = ggv[mi], u4 = uuv[mi];
        u32x4 w; w.x = pg8::cvt_pk_bf16(a[0] * pg8::bflo(u4.x) * pg8::bflo(g4.x), a[1] * pg8::bfhi(u4.x) * pg8::bfhi(g4.x)); w.y = pg8::cvt_pk_bf16(a[2] * pg8::bflo(u4.y) * pg8::bflo(g4.y), a[3] * pg8::bfhi(u4.y) * pg8::bfhi(g4.y));
        w.z = pg8::cvt_pk_bf16(b[0] * pg8::bflo(u4.z) * pg8::bflo(g4.z), b[1] * pg8::bfhi(u4.z) * pg8::bfhi(g4.z)); w.w = pg8::cvt_pk_bf16(b[2] * pg8::bflo(u4.w) * pg8::bflo(g4.w), b[3] * pg8::bfhi(u4.w) * pg8::bfhi(g4.w));
        if (do_store) *(u32x4*)(R1 + (size_t)t * R1_LD + 1024 + g * 128 + cst) = w; }
    __syncthreads();
}

#define RLX_AGENT __ATOMIC_RELAXED, __HIP_MEMORY_SCOPE_AGENT
#define XB_TMO      128
#define XB_XCNT(j)  (256  + 64 * (j))
#define XB_XSUB(j)  (1280 + 64 * (j))
#define XB_XGEN(j)  (2304 + 64 * (j))
#define XB_TOP      3328
#define XB_TOPGEN   3392
#define XCD_BAR_WORDS 3456
#define XB_SPIN_CAP (1u << 18)

__device__ __forceinline__ unsigned xb_ld(unsigned* p)              { return __hip_atomic_load(p, __ATOMIC_RELAXED, __HIP_MEMORY_SCOPE_AGENT); }
__device__ __forceinline__ unsigned xb_add(unsigned* p, unsigned v) { return __hip_atomic_fetch_add(p, v, __ATOMIC_RELAXED, __HIP_MEMORY_SCOPE_AGENT); }
__device__ __forceinline__ unsigned xb_xcc_id() { return (unsigned)__builtin_amdgcn_s_getreg((3 << 11) | 20) & 0xFu; }
#define XB_SPIN(cond, bar) do { unsigned _sp = 0; while (cond) { __builtin_amdgcn_s_sleep(1); \
    if ((++_sp & 255u) == 0u) { if (xb_ld(&(bar)[XB_TMO])) break; if (_sp > XB_SPIN_CAP) { atomicAdd(&(bar)[XB_TMO], 1u); break; } } } } while (0)

struct XcdBarrier {
    unsigned* bar; unsigned x;
    volatile LAS unsigned* st;
};

__device__ __forceinline__ XcdBarrier xcd_barrier_post(unsigned* bar, volatile LAS unsigned* st) {
    XcdBarrier b; b.bar = bar; b.x = xb_xcc_id(); b.st = st;
    if (threadIdx.x == 0) (void)xb_add(&bar[XB_XCNT(b.x)], 1u);
    return b;
}
__device__ __forceinline__ void xcd_barrier_complete(unsigned* bar, unsigned x, unsigned& nloc, unsigned& nx) {
    const unsigned G = gridDim.x * gridDim.y * gridDim.z;
    unsigned sum, cnt, mine, sp = 0u;
    for (;;) {
        sum = 0u; cnt = 0u; mine = 0u;
#pragma unroll
        for (unsigned j = 0; j < 16; ++j) { const unsigned c = xb_ld(&bar[XB_XCNT(j)]); sum += c; cnt += (c > 0u) ? 1u : 0u; mine = (j == x) ? c : mine; }
        if (sum == G) break;
        __builtin_amdgcn_s_sleep(1);
        if ((++sp & 255u) == 0u) { if (xb_ld(&bar[XB_TMO])) break; if (sp > XB_SPIN_CAP) { atomicAdd(&bar[XB_TMO], 1u); break; } }
    }
    nloc = mine > 0u ? mine : 1u; nx = cnt > 0u ? cnt : 1u;
}

__device__ __forceinline__ void xcd_barrier(const XcdBarrier& b) {
    asm volatile("s_waitcnt vmcnt(0)" ::: "memory");
    __syncthreads();
    if (threadIdx.x == 0) {
        unsigned* bar = b.bar;
        __builtin_amdgcn_s_waitcnt(0);
        unsigned nloc = b.st[0], nx = b.st[1];
        if (nloc == 0u) { xcd_barrier_complete(bar, b.x, nloc, nx); b.st[0] = nloc; b.st[1] = nx; }
        const unsigned old = xb_add(&bar[XB_XSUB(b.x)], 1u);
        const unsigned gen = old / nloc;
        if (old + 1u == (gen + 1u) * nloc) {
            __builtin_amdgcn_fence(__ATOMIC_RELEASE, "agent");
            asm volatile("s_waitcnt vmcnt(0)" ::: "memory");
            const unsigned og = xb_add(&bar[XB_TOP], 1u);
            const unsigned tg = og / nx;
            if (og + 1u == (tg + 1u) * nx) xb_add(&bar[XB_TOPGEN], 1u);
            else XB_SPIN(xb_ld(&bar[XB_TOPGEN]) == tg, bar);
            __builtin_amdgcn_fence(__ATOMIC_ACQUIRE, "agent");
            asm volatile("s_waitcnt vmcnt(0)" ::: "memory");
        } else {
            XB_SPIN(xb_ld(&bar[XB_TOPGEN]) == gen, bar);
            __builtin_amdgcn_fence(__ATOMIC_ACQUIRE, "agent");
            asm volatile("s_waitcnt vmcnt(0)" ::: "memory");
        }
    }
    __syncthreads();
}

constexpr int N_PHASES = 1 + 6 * DEPTH;
typedef const __attribute__((address_space(4))) Args* KArgs;
#define FRESH_ARGS() KArgs ap = (KArgs)__builtin_amdgcn_kernarg_segment_ptr(); asm volatile("" : "+s"(ap)); unsigned char* ws = ap->ws
__global__ void __launch_bounds__(NTHREADS, 2) hybrid_fwd(Args a_unused) {
    extern __shared__ __attribute__((aligned(16))) unsigned char lds_raw[];
    LAS unsigned char* lds = (LAS unsigned char*)lds_raw;
    cg::grid_group grid = cg::this_grid();
    int lo, hi; { FRESH_ARGS(); (void)ws; lo = ap->ph_lo; hi = ap->ph_hi; }
    if (threadIdx.x < 2) ((volatile LAS unsigned*)(lds + LDS_BYTES - 64))[threadIdx.x] = 0u;
    __syncthreads();
    if (lo < 0) grid.sync();
    XcdBarrier xbar; { FRESH_ARGS(); xbar = xcd_barrier_post((unsigned*)(ws + WS_CTL), (volatile LAS unsigned*)(lds + LDS_BYTES - 64)); }
#define GV() const int G = gridDim.x, bx = blockIdx.x; const int vcu = (G % 8 == 0) ? (bx % 8) * (G / 8) + bx / 8 : bx; (void)vcu; (void)bx
#define IN(k) (lo <= (k) && (k) < hi)
#ifdef SEAM2
#define SEAM(k) do { if (IN(k) && IN((k) + 1)) { xcd_barrier(xbar); xcd_barrier(xbar); } } while (0)
#else
#define SEAM(k) do { if (IN(k) && IN((k) + 1)) xcd_barrier(xbar); } while (0)
#endif

#ifndef SKIP_P0
    if (IN(0)) { FRESH_ARGS(); GV(); P0Args a{ap->x, ap->pre_g, ap->w_in, ap->w_merge, ap->w_branch, ap->w_out, ap->pool_w, ap->sgu_w, ws}; p0_prologue(a, lds, vcu, G); __syncthreads();
#ifdef REP_P0
        p0_prologue(a, lds, vcu, G); __syncthreads();
#endif
    }
#endif
    SEAM(0);
#pragma unroll 1
    for (int l = 0; l < DEPTH; ++l) {
        const int pb = 1 + 6 * l;
#ifndef SKIP_P1
        if (IN(pb)) { FRESH_ARGS(); GV();
            pg8::Gemm g{(bf16_t*)(ws + WS_H), (bf16_t*)(ws + WS_WCAT) + l * WCAT_L, 1024, 1024, 1024, 0}; pg8::StaticOrderH S; S.init(M, INW, G, bx);
            pg8::EpiZ E{(bf16_t*)(ws + WS_R1), (bf16_t*)(ws + WS_R2), (bf16_t*)(ws + WS_VT), (f32x2*)(ws + WS_SVST)};
#ifdef REP_P1
            pg8::gemm_phase<pg8::EpiZ, pg8::StaticOrderH, true, true>(lds, g, S, E);
#endif
            pg8::gemm_phase<pg8::EpiZ, pg8::StaticOrderH, true, true>(lds, g, S, E);
        }
#endif
        SEAM(pb);
#ifndef SKIP_P2
        if (IN(pb + 1)) { FRESH_ARGS(); GV();
            const int lane = opaque_tid() & 63;
            bf16_t* R1 = (bf16_t*)(ws + WS_R1); const bf16_t* R2 = (const bf16_t*)(ws + WS_R2); const bf16_t* VT = (const bf16_t*)(ws + WS_VT);
            float lam, omli;
            { const float a1 = wave_sum(ap->lq1[l * 64 + lane] * ap->lk1[l * 64 + lane]), a2 = wave_sum(ap->lq2[l * 64 + lane] * ap->lk2[l * 64 + lane]);
              const float li = 0.8f - 0.6f * __expf(-0.3f * (float)l); lam = __expf(a1) - __expf(a2) + li; omli = 1.0f - li; }
            const float* subln = ap->subln_g + l * 128;
#ifdef REP_ATT
            for (int rep = 0; rep < 2; ++rep) { const bool st = (rep == 1) ? (lo >= 0) : (lo < 0);
#else
            { const bool st = true;
#endif
            for (int pr = vcu; pr < 256; pr += G) { const int bh = pr >> 3, i = pr & 7;
                attn_unit(bh >> 2, bh & 3, 15 - i, R1, R2, VT, subln, lam, omli, lds, st);
                attn_unit(bh >> 2, bh & 3, i, R1, R2, VT, subln, lam, omli, lds, st); } }
            const bf16_t* PWl = (const bf16_t*)(ws + WS_PW) + (size_t)l * 4 * 128 * 128; const bf16_t* SWl = (const bf16_t*)(ws + WS_SW) + (size_t)l * 4 * 128 * 128;
#ifdef REP_MIX
            for (int rep = 0; rep < 2; ++rep) { const bool st = (rep == 1) ? (lo >= 0) : (lo < 0);
#else
            { const bool st = true;
#endif
            for (int u = vcu; u < 1024; u += G) { const int w_ = u & 511, rnd = w_ >> 8, vv = w_ & 255; const int tb = rnd * 64 + (vv >> 2), g = rnd ? 3 - (vv & 3) : (vv & 3);
                if (u < 512) pool_unit(tb, g, R1, R2, PWl, ap->pool_b + l * 512, ap->pool_scale + l * 512, lds, st);
                else sgu_unit(tb, g, R1, R2, SWl, ap->sgu_ln_g + l * 512, ap->sgu_ln_b + l * 512, ap->sgu_b + l * 512, (const f32x2*)(ws + WS_SVST), lds, st); } }
        }
#endif
        SEAM(pb + 1);
#ifndef SKIP_P25
        if (IN(pb + 2)) { FRESH_ARGS(); GV();
            pg8::Gemm g{(bf16_t*)(ws + WS_H), (bf16_t*)(ws + WS_WCAT) + l * WCAT_L + (size_t)INW * 1024, 1024, 1024, 1024, 0}; pg8::StaticOrder S; S.init(M, GATEW, G, bx);
            pg8::EpiGate E{(bf16_t*)(ws + WS_GATE), ap->b_merge + l * GATEW};
#ifdef REP_P25
            pg8::gemm_phase<pg8::EpiGate, pg8::StaticOrder, true, true>(lds, g, S, E);
#endif
            pg8::gemm_phase<pg8::EpiGate, pg8::StaticOrder, true, true>(lds, g, S, E);
        }
#endif
        SEAM(pb + 2);
#ifndef SKIP_P3
        if (IN(pb + 3)) { FRESH_ARGS(); GV();
            pg8::Gemm g{(bf16_t*)(ws + WS_R1), (bf16_t*)(ws + WS_WB) + l * WB_L, 1536, 1536, 512, 1024}; pg8::StaticOrder3 S; S.init(M, D, G, bx);
            pg8::EpiMerge E{(bf16_t*)(ws + WS_GATE), (bf16_t*)(ws + WS_H)};
#ifdef REP_P3
            pg8::gemm_phase<pg8::EpiMerge, pg8::StaticOrder3, true, true>(lds, g, S, E);
#endif
            pg8::gemm_phase<pg8::EpiMerge, pg8::StaticOrder3, true, true>(lds, g, S, E);
        }
#endif
        SEAM(pb + 3);
#ifndef SKIP_P4
        if (IN(pb + 4)) { FRESH_ARGS(); GV();
            pg8::Gemm g{(bf16_t*)(ws + WS_H), (bf16_t*)(ws + WS_WO) + l * WO_L, 1024, 1024, 1024, 0}; pg8::StaticOrder S; S.init(M, D, G, bx);
            pg8::EpiOut E{(bf16_t*)(ws + WS_OUT), (float*)(ws + WS_SSQ)};
#ifdef REP_P4
            pg8::gemm_phase<pg8::EpiOut, pg8::StaticOrder, true, true>(lds, g, S, E);
#endif
            pg8::gemm_phase<pg8::EpiOut, pg8::StaticOrder, true, true>(lds, g, S, E);
        }
#endif
        SEAM(pb + 4);
#ifndef SKIP_P5
        if (IN(pb + 5)) { FRESH_ARGS(); GV();
#ifdef REP_P5L0
            if (l == 0) p5_rows<false, true>(ap->x, (const bf16_t*)(ws + WS_OUT), (const float*)(ws + WS_SSQ), ap->post_g + l * D, ap->pre_g + (l + 1) * D, ws + WS_X1, (bf16_t*)(ws + WS_H), vcu, G);
#endif
            if (l + 1 < DEPTH) p5_rows<false, true>(ap->x, (const bf16_t*)(ws + WS_OUT), (const float*)(ws + WS_SSQ), ap->post_g + l * D, ap->pre_g + (l + 1) * D, ws + WS_X1, (bf16_t*)(ws + WS_H), vcu, G);
            else p5_rows<true, false>(ws + WS_X1, (const bf16_t*)(ws + WS_OUT), (const float*)(ws + WS_SSQ), ap->post_g + l * D, nullptr, ap->out, (bf16_t*)(ws + WS_H), vcu, G);
        }
#endif
        SEAM(pb + 5);
    }
#undef IN
#undef SEAM
}

#ifndef MK_N_LAUNCHES
#define MK_N_LAUNCHES 1
#endif
extern "C" void kernel_launch(void* const* d_in, const int* in_sizes, int n_in, void* d_out, int out_size, void* d_ws, size_t ws_size, hipStream_t stream) {
    static int grid = 0;
    if (grid == 0) {
        if (n_in != 20 || in_sizes[0] != M * D || out_size != M * D || ws_size < WS_END) { fprintf(stderr, "kernel_launch: unexpected shapes (n_in %d in0 %d out %d ws %zu)\n", n_in, n_in > 0 ? in_sizes[0] : -1, out_size, ws_size); grid = -1; return; }
        int dev = 0, cus = 0, per_cu = 0;
        hipGetDevice(&dev); hipDeviceGetAttribute(&cus, hipDeviceAttributeMultiprocessorCount, dev);
        if (hipFuncSetAttribute((const void*)hybrid_fwd, hipFuncAttributeMaxDynamicSharedMemorySize, LDS_BYTES) != hipSuccess) { fprintf(stderr, "kernel_launch: hipFuncSetAttribute failed\n"); grid = -1; return; }
        if (hipOccupancyMaxActiveBlocksPerMultiprocessor(&per_cu, (const void*)hybrid_fwd, NTHREADS, LDS_BYTES) != hipSuccess || per_cu < 1) { fprintf(stderr, "kernel_launch: occupancy query says %d\n", per_cu); per_cu = 1; }
        (void)hipGetLastError();
        grid = cus * (per_cu > 1 ? 1 : per_cu);
        fprintf(stderr, "kernel_launch: grid %d (cus %d, per_cu %d)\n", grid, cus, per_cu);
    }
    if (grid < 0) return;
    Args a{};
    const float* const* in = (const float* const*)d_in;
    a.x = in[0]; a.pre_g = in[1]; a.post_g = in[2]; a.w_in = in[3]; a.lq1 = in[4]; a.lk1 = in[5]; a.lq2 = in[6]; a.lk2 = in[7];
    a.subln_g = in[8]; a.pool_w = in[9]; a.pool_b = in[10]; a.pool_scale = in[11]; a.sgu_ln_g = in[12]; a.sgu_ln_b = in[13]; a.sgu_w = in[14]; a.sgu_b = in[15];
    a.w_branch = in[16]; a.w_merge = in[17]; a.b_merge = in[18]; a.w_out = in[19];
    a.out = (float*)d_out; a.ws = (unsigned char*)d_ws;
    if (hipMemsetAsync((unsigned char*)d_ws + WS_CTL, 0, XCD_BAR_WORDS * 4, stream) != hipSuccess) { fprintf(stderr, "kernel_launch: memset failed\n"); return; }
#if MK_N_LAUNCHES == 1
    a.ph_lo = 0; a.ph_hi = N_PHASES;
    void* args[] = {&a};
    hipError_t e = hipLaunchCooperativeKernel((const void*)hybrid_fwd, dim3(grid), dim3(NTHREADS), args, LDS_BYTES, stream);
    if (e != hipSuccess) fprintf(stderr, "cooperative launch failed: %s (grid %d)\n", hipGetErrorString(e), grid);
#else
    for (int p = 0; p < N_PHASES; ++p) { a.ph_lo = p; a.ph_hi = p + 1; hipLaunchKernelGGL(hybrid_fwd, dim3(grid), dim3(NTHREADS), LDS_BYTES, stream, a); }
#endif
}
```
